# Optimizing an MI355X kernel written in HIP

```python
import math
import jax, jax.numpy as jnp
from jax import lax
import numpy as np

D_MODEL = 1024
BATCH = 8
SEQ = 4096
DEPTH = 1

CHUNK = 64
Q_BLOCK = 128
MEM_LEN = 256
MIX_WIDTH = D_MODEL
FOX_WIDTH = MIX_WIDTH // 2
FOX_HEADS = 8
FOX_HEAD_DIM = FOX_WIDTH // FOX_HEADS
GLA_WIDTH = MIX_WIDTH - FOX_WIDTH
GLA_HEADS = 4
GLA_VAL_DIM = GLA_WIDTH // GLA_HEADS
GLA_KEY_DIM = GLA_VAL_DIM // 2
GLA_QK = GLA_HEADS * GLA_KEY_DIM
GLA_GATE_RANK = 16
GLA_GATE_NORM = 16.0
MEM_HEADS = 4
MEM_HEAD_DIM = D_MODEL // MEM_HEADS
D_FF = 128 * (-(-8 * D_MODEL // (3 * 128)))
RMS_EPS = 1e-6

OFF_FQ = 0
OFF_FK = OFF_FQ + FOX_WIDTH
OFF_FV = OFF_FK + FOX_WIDTH
OFF_FF = OFF_FV + FOX_WIDTH
OFF_GQ = OFF_FF + FOX_HEADS
OFF_GK = OFF_GQ + GLA_QK
OFF_GV = OFF_GK + GLA_QK
OFF_GG = OFF_GV + GLA_WIDTH
OFF_GR = OFF_GG + GLA_GATE_RANK
IN_WIDTH = OFF_GR + GLA_WIDTH

kernel_name = 'hybrid_fox_gla_macaron_memory_layer'

F32 = jnp.float32


def rms_norm(x, g):
    xf = x.astype(F32)
    y = xf * lax.rsqrt(jnp.mean(xf * xf, axis=-1, keepdims=True) + RMS_EPS)
    return (y * g.astype(F32)).astype(x.dtype)


def head_rms_norm(o, g):
    B, S, H, d = o.shape
    y = o * lax.rsqrt(jnp.mean(o * o, axis=-1, keepdims=True) + RMS_EPS)
    return (y * g.astype(F32).reshape(H, d)).reshape(B, S, H * d)


def swiglu(h, w_gate, w_up, w_down):
    return (jax.nn.silu(h @ w_gate) * (h @ w_up)) @ w_down


def forgetting_attention(q, k, v, log_f):
    B, S, H, dh = q.shape
    qf = (q.astype(F32) * (dh ** -0.5)).transpose(0, 2, 1, 3)
    kf = k.astype(F32).transpose(0, 2, 1, 3)
    vf = v.astype(F32).transpose(0, 2, 1, 3)
    c = jnp.cumsum(log_f, axis=1).transpose(0, 2, 1)
    outs = []
    for i in range(S // Q_BLOCK):
        q0 = i * Q_BLOCK
        L = q0 + Q_BLOCK
        s = jnp.einsum('bhqd,bhkd->bhqk', qf[:, :, q0:L], kf[:, :, :L])
        s = s + c[:, :, q0:L, None] - c[:, :, None, :L]
        mask = jnp.arange(L)[None, :] <= (q0 + jnp.arange(Q_BLOCK))[:, None]
        p = jax.nn.softmax(jnp.where(mask, s, -jnp.inf), axis=-1)
        outs.append(jnp.einsum('bhqk,bhkd->bhqd', p, vf[:, :, :L]))
    return jnp.concatenate(outs, axis=2).transpose(0, 2, 1, 3)


def gla_chunked(q, k, v, log_a):
    B, S, H, dk = q.shape
    dv = v.shape[-1]
    N = S // CHUNK

    def to_chunks(t):
        return t.astype(F32).reshape(B, N, CHUNK, H, t.shape[-1]).transpose(0, 3, 1, 2, 4)

    qc = to_chunks(q) * (dk ** -0.5)
    kc = to_chunks(k)
    vc = to_chunks(v)
    b = jnp.cumsum(to_chunks(log_a), axis=3)
    b_last = b[:, :, :, -1:, :]
    q_dec = qc * jnp.exp(b)
    k_inv = kc * jnp.exp(-b)
    causal = jnp.tril(jnp.ones((CHUNK, CHUNK), dtype=bool))
    att = jnp.where(causal, jnp.einsum('bhncd,bhnsd->bhncs', q_dec, k_inv), 0.0)
    o_intra = jnp.einsum('bhncs,bhnse->bhnce', att, vc)
    kv = jnp.einsum('bhncd,bhnce->bhnde', kc * jnp.exp(b_last - b), vc)
    decay = jnp.exp(b_last[:, :, :, 0, :])

    def step(state, inp):
        dec, kv_n = inp
        return dec[..., None] * state + kv_n, state

    s0 = jnp.zeros((B, H, dk, dv), F32)
    _, s_prev = lax.scan(step, s0, (jnp.moveaxis(decay, 2, 0), jnp.moveaxis(kv, 2, 0)))
    s_prev = jnp.moveaxis(s_prev, 0, 2)
    o = o_intra + jnp.einsum('bhncd,bhnde->bhnce', q_dec, s_prev)
    return o.transpose(0, 2, 3, 1, 4).reshape(B, S, H, dv)


def hybrid_mixer(h, w_in, b_f, w_g2, b_g, g_fox_out, g_gla_out, w_out):
    B, S, _ = h.shape
    z = h @ w_in
    fq = z[..., OFF_FQ:OFF_FK].reshape(B, S, FOX_HEADS, FOX_HEAD_DIM)
    fk = z[..., OFF_FK:OFF_FV].reshape(B, S, FOX_HEADS, FOX_HEAD_DIM)
    fv = z[..., OFF_FV:OFF_FF].reshape(B, S, FOX_HEADS, FOX_HEAD_DIM)
    log_f = jax.nn.log_sigmoid((z[..., OFF_FF:OFF_GQ] + b_f).astype(F32))
    o_fox = head_rms_norm(forgetting_attention(fq, fk, fv, log_f), g_fox_out)
    gq = z[..., OFF_GQ:OFF_GK].reshape(B, S, GLA_HEADS, GLA_KEY_DIM)
    gk = z[..., OFF_GK:OFF_GV].reshape(B, S, GLA_HEADS, GLA_KEY_DIM)
    gv = z[..., OFF_GV:OFF_GG].reshape(B, S, GLA_HEADS, GLA_VAL_DIM)
    gate = (z[..., OFF_GG:OFF_GR] @ w_g2 + b_g).astype(F32)
    log_a = (jax.nn.log_sigmoid(gate) / GLA_GATE_NORM).reshape(B, S, GLA_HEADS, GLA_KEY_DIM)
    o_gla = head_rms_norm(gla_chunked(gq, gk, gv, log_a), g_gla_out)
    o_gla = o_gla * jax.nn.silu(z[..., OFF_GR:IN_WIDTH].astype(F32))
    o = jnp.concatenate([o_fox, o_gla], axis=-1).astype(h.dtype)
    return o @ w_out


def memory_cross_attention(h, m, w_q, w_kv, w_o):
    B, S, _ = h.shape
    M = m.shape[1]
    q = (h @ w_q).reshape(B, S, MEM_HEADS, MEM_HEAD_DIM).astype(F32)
    kv = (m @ w_kv).reshape(B, M, 2, MEM_HEADS, MEM_HEAD_DIM).astype(F32)
    s = jnp.einsum('bqhd,bkhd->bhqk', q, kv[:, :, 0]) * (MEM_HEAD_DIM ** -0.5)
    p = jax.nn.softmax(s, axis=-1)
    o = jnp.einsum('bhqk,bkhd->bqhd', p, kv[:, :, 1]).reshape(B, S, MEM_HEADS * MEM_HEAD_DIM)
    return o.astype(h.dtype) @ w_o


def setup_inputs(seed: int = 0) -> dict:
    key = jax.random.key(seed)
    ks = iter(jax.random.split(key, 32))

    def normal(shape, scale):
        return jax.random.normal(next(ks), shape, F32) * scale

    def gain(n):
        return 1.0 + normal((DEPTH, n), 0.1)

    Ld = DEPTH
    return {
        'x': normal((BATCH, SEQ, D_MODEL), 1.0),
        'mem': normal((BATCH, MEM_LEN, D_MODEL), 1.0),
        'g_ff1_pre': gain(D_MODEL),
        'w_ff1_gate': normal((Ld, D_MODEL, D_FF), D_MODEL ** -0.5),
        'w_ff1_up': normal((Ld, D_MODEL, D_FF), D_MODEL ** -0.5),
        'w_ff1_down': normal((Ld, D_FF, D_MODEL), D_FF ** -0.5),
        'g_ff1_post': gain(D_MODEL),
        'g_mix_pre': gain(D_MODEL),
        'w_mix_in': normal((Ld, D_MODEL, IN_WIDTH), D_MODEL ** -0.5),
        'b_fox_f': 2.0 + normal((Ld, FOX_HEADS), 0.5),
        'w_gla_g2': normal((Ld, GLA_GATE_RANK, GLA_QK), GLA_GATE_RANK ** -0.5),
        'b_gla_g': normal((Ld, GLA_QK), 0.1),
        'g_fox_out': gain(FOX_WIDTH),
        'g_gla_out': gain(GLA_WIDTH),
        'w_mix_out': normal((Ld, MIX_WIDTH, D_MODEL), MIX_WIDTH ** -0.5),
        'g_mix_post': gain(D_MODEL),
        'g_mem_pre': gain(D_MODEL),
        'g_mem_src': gain(D_MODEL),
        'w_mem_q': normal((Ld, D_MODEL, MEM_HEADS * MEM_HEAD_DIM), D_MODEL ** -0.5),
        'w_mem_kv': normal((Ld, D_MODEL, 2 * MEM_HEADS * MEM_HEAD_DIM), D_MODEL ** -0.5),
        'w_mem_o': normal((Ld, MEM_HEADS * MEM_HEAD_DIM, D_MODEL), (MEM_HEADS * MEM_HEAD_DIM) ** -0.5),
        'g_mem_post': gain(D_MODEL),
        'g_ff2_pre': gain(D_MODEL),
        'w_ff2_gate': normal((Ld, D_MODEL, D_FF), D_MODEL ** -0.5),
        'w_ff2_up': normal((Ld, D_MODEL, D_FF), D_MODEL ** -0.5),
        'w_ff2_down': normal((Ld, D_FF, D_MODEL), D_FF ** -0.5),
        'g_ff2_post': gain(D_MODEL),
        'g_final': 1.0 + normal((D_MODEL,), 0.1),
    }


def reference(x, mem, g_ff1_pre, w_ff1_gate, w_ff1_up, w_ff1_down, g_ff1_post,
              g_mix_pre, w_mix_in, b_fox_f, w_gla_g2, b_gla_g, g_fox_out, g_gla_out,
              w_mix_out, g_mix_post, g_mem_pre, g_mem_src, w_mem_q, w_mem_kv, w_mem_o,
              g_mem_post, g_ff2_pre, w_ff2_gate, w_ff2_up, w_ff2_down, g_ff2_post, g_final):
    for l in range(DEPTH):
        y = swiglu(rms_norm(x, g_ff1_pre[l]), w_ff1_gate[l], w_ff1_up[l], w_ff1_down[l])
        x = x + 0.5 * rms_norm(y, g_ff1_post[l])
        y = hybrid_mixer(rms_norm(x, g_mix_pre[l]), w_mix_in[l], b_fox_f[l], w_gla_g2[l],
                         b_gla_g[l], g_fox_out[l], g_gla_out[l], w_mix_out[l])
        x = x + rms_norm(y, g_mix_post[l])
        y = memory_cross_attention(rms_norm(x, g_mem_pre[l]), rms_norm(mem, g_mem_src[l]),
                                   w_mem_q[l], w_mem_kv[l], w_mem_o[l])
        x = x + rms_norm(y, g_mem_post[l])
        y = swiglu(rms_norm(x, g_ff2_pre[l]), w_ff2_gate[l], w_ff2_up[l], w_ff2_down[l])
        x = x + 0.5 * rms_norm(y, g_ff2_post[l])
    return rms_norm(x, g_final)
```

```cpp
#include <hip/hip_runtime.h>
#include <cstdint>
#include <cstdio>

namespace nv {
constexpr int NB = 8, S = 4096, D = 1024, DFF = 2816, INW = 3096, ML = 256;
constexpr int OFF_FQ = 0, OFF_FK = 512, OFF_FV = 1024, OFF_FF = 1536, OFF_GQ = 1544, OFF_GK = 1800, OFF_GV = 2056, OFF_GG = 2568, OFF_GR = 2584;
constexpr float EPS = 1e-6f;

__global__ void __launch_bounds__(256) gemm_f32(const float* __restrict__ A, int lda, const float* __restrict__ W, int ldw, float* __restrict__ C, int ldc, int M, int N, int K) {
    __shared__ float As[16][68];
    __shared__ float Ws[16][68];
    const int tid = threadIdx.x, tx = tid & 15, ty = tid >> 4;
    const int m0 = blockIdx.y * 64, n0 = blockIdx.x * 64;
    float acc[4][4] = {};
    for (int k0 = 0; k0 < K; k0 += 16) {
#pragma unroll
        for (int i = 0; i < 4; ++i) { const int e = tid + i * 256; const int r = e >> 4, c = e & 15; As[c][r] = A[(size_t)(m0 + r) * lda + k0 + c]; }
#pragma unroll
        for (int i = 0; i < 4; ++i) { const int e = tid + i * 256; const int r = e >> 6, c = e & 63; Ws[r][c] = (n0 + c < N) ? W[(size_t)(k0 + r) * ldw + n0 + c] : 0.f; }
        __syncthreads();
#pragma unroll
        for (int k = 0; k < 16; ++k) {
            float a[4], b[4];
#pragma unroll
            for (int i = 0; i < 4; ++i) { a[i] = As[k][ty * 4 + i]; b[i] = Ws[k][tx * 4 + i]; }
#pragma unroll
            for (int i = 0; i < 4; ++i)
#pragma unroll
                for (int j = 0; j < 4; ++j) acc[i][j] = fmaf(a[i], b[j], acc[i][j]);
        }
        __syncthreads();
    }
#pragma unroll
    for (int i = 0; i < 4; ++i)
#pragma unroll
        for (int j = 0; j < 4; ++j) { const int n = n0 + tx * 4 + j; if (n < N) C[(size_t)(m0 + ty * 4 + i) * ldc + n] = acc[i][j]; }
}

__device__ __forceinline__ float wave_sum(float v) {
#pragma unroll
    for (int o = 1; o < 64; o <<= 1) v += __shfl_xor(v, o);
    return v;
}
__global__ void __launch_bounds__(256) rms_rows(const float* __restrict__ in, const float* __restrict__ g, const float* base, float alpha, float* out, int rows) {
    const int row = blockIdx.x * 4 + (threadIdx.x >> 6), lane = threadIdx.x & 63;
    if (row >= rows) return;
    const float* x = in + (size_t)row * D;
    float v[16]; float s = 0.f;
#pragma unroll
    for (int j = 0; j < 16; ++j) { v[j] = x[lane + 64 * j]; s += v[j] * v[j]; }
    const float r = 1.0f / sqrtf(wave_sum(s) * (1.0f / D) + EPS);
#pragma unroll
    for (int j = 0; j < 16; ++j) { const int c = lane + 64 * j; float o = v[j] * r * g[c]; if (base) o = base[(size_t)row * D + c] + alpha * o; out[(size_t)row * D + c] = o; }
}
__global__ void swiglu_ew(float* G, const float* U, size_t n) {
    const size_t i = (size_t)blockIdx.x * 256 + threadIdx.x; if (i >= n) return;
    const float g = G[i]; G[i] = g / (1.0f + expf(-g)) * U[i];
}
__device__ __forceinline__ float logsigmoid(float x) { return fminf(x, 0.f) - log1pf(expf(-fabsf(x))); }
__global__ void fox_cumsum(const float* z, const float* bf, float* c) {
    const int h = threadIdx.x; if (h >= 8) return;
    float acc = 0.f;
    for (int t = 0; t < S; ++t) { acc += logsigmoid(z[(size_t)t * INW + OFF_FF + h] + bf[h]); c[t * 8 + h] = acc; }
}
__global__ void __launch_bounds__(64) fox_attn(const float* __restrict__ z, const float* __restrict__ c, const float* __restrict__ gfo, float* omix) {
    const int h = blockIdx.y, t = blockIdx.x * 64 + threadIdx.x;
    float q[64], o[64];
#pragma unroll
    for (int d = 0; d < 64; ++d) { q[d] = z[(size_t)t * INW + OFF_FQ + h * 64 + d] * 0.125f; o[d] = 0.f; }
    const float ct = c[t * 8 + h];
    float m = -INFINITY, l = 0.f;
    const int tmax = blockIdx.x * 64 + 63;
    for (int s = 0; s <= tmax; ++s) {
        const float* kr = z + (size_t)s * INW + OFF_FK + h * 64; const float* vr = z + (size_t)s * INW + OFF_FV + h * 64;
        float sc = 0.f;
#pragma unroll
        for (int d = 0; d < 64; ++d) sc = fmaf(q[d], kr[d], sc);
        sc += ct - c[s * 8 + h];
        if (s <= t) {
            const float mn = fmaxf(m, sc), f = expf(m - mn), p = expf(sc - mn);
            l = l * f + p;
#pragma unroll
            for (int d = 0; d < 64; ++d) o[d] = o[d] * f + p * vr[d];
            m = mn;
        }
    }
    float ss = 0.f;
#pragma unroll
    for (int d = 0; d < 64; ++d) { o[d] /= l; ss += o[d] * o[d]; }
    const float r = 1.0f / sqrtf(ss * (1.0f / 64) + EPS);
#pragma unroll
    for (int d = 0; d < 64; ++d) omix[(size_t)t * D + h * 64 + d] = o[d] * r * gfo[h * 64 + d];
}
__global__ void gla_gate(const float* z, const float* wg2, const float* bg, float* la) {
    const int t = blockIdx.x, j = threadIdx.x;
    float a = bg[j];
#pragma unroll
    for (int r = 0; r < 16; ++r) a = fmaf(z[(size_t)t * INW + OFF_GG + r], wg2[r * 256 + j], a);
    la[t * 256 + j] = expf(logsigmoid(a) * (1.0f / 16.0f));
}
__global__ void __launch_bounds__(128) gla_rec(const float* __restrict__ z, const float* __restrict__ la, const float* __restrict__ ggo, float* omix) {
    __shared__ float red[2];
    const int h = blockIdx.x, j = threadIdx.x;
    float Sst[64];
#pragma unroll
    for (int i = 0; i < 64; ++i) Sst[i] = 0.f;
    for (int t = 0; t < S; ++t) {
        const float* zr = z + (size_t)t * INW;
        const float v = zr[OFF_GV + h * 128 + j];
        float o = 0.f;
#pragma unroll
        for (int i = 0; i < 64; ++i) {
            const float a = la[t * 256 + h * 64 + i];
            Sst[i] = fmaf(a, Sst[i], zr[OFF_GK + h * 64 + i] * v);
            o = fmaf(zr[OFF_GQ + h * 64 + i] * 0.125f, Sst[i], o);
        }
        float ss = wave_sum(o * o);
        __syncthreads();
        if ((j & 63) == 0) red[j >> 6] = ss;
        __syncthreads();
        ss = red[0] + red[1];
        const float r = 1.0f / sqrtf(ss * (1.0f / 128) + EPS);
        const float gr = zr[OFF_GR + h * 128 + j];
        omix[(size_t)t * D + 512 + h * 128 + j] = o * r * ggo[h * 128 + j] * (gr / (1.0f + expf(-gr)));
    }
}
__global__ void __launch_bounds__(256) mem_attn(const float* __restrict__ qm, const float* __restrict__ kvm, float* om) {
    __shared__ float qs[256]; __shared__ float ps[256]; __shared__ float red[4];
    const int t = blockIdx.x, h = blockIdx.y, k = threadIdx.x;
    qs[k] = qm[(size_t)t * D + h * 256 + k];
    __syncthreads();
    const float* kr = kvm + (size_t)k * 2048 + h * 256;
    float sc = 0.f;
    for (int d = 0; d < 256; ++d) sc = fmaf(qs[d], kr[d], sc);
    sc *= 0.0625f;
    float mx = sc;
#pragma unroll
    for (int o = 1; o < 64; o <<= 1) mx = fmaxf(mx, __shfl_xor(mx, o));
    if ((k & 63) == 0) red[k >> 6] = mx;
    __syncthreads();
    mx = fmaxf(fmaxf(red[0], red[1]), fmaxf(red[2], red[3]));
    __syncthreads();
    const float p = expf(sc - mx);
    float sm = wave_sum(p);
    if ((k & 63) == 0) red[k >> 6] = sm;
    ps[k] = p;
    __syncthreads();
    sm = red[0] + red[1] + red[2] + red[3];
    float o = 0.f;
    for (int kk = 0; kk < 256; ++kk) o = fmaf(ps[kk], kvm[(size_t)kk * 2048 + 1024 + h * 256 + k], o);
    om[(size_t)t * D + h * 256 + k] = o / sm;
}
}

extern "C" void kernel_launch(void* const* d_in, const int* in_sizes, int n_in, void* d_out, int out_size, void* d_ws, size_t ws_size, hipStream_t stream) {
    using namespace nv;
    const float* const* in = (const float* const*)d_in;
    float* out = (float*)d_out;
    float* ws = (float*)d_ws;
    size_t off = 0;
    auto take = [&](size_t n) { float* p = ws + off; off += n; return p; };
    float* xn = take((size_t)S * D);
    float* Gb = take((size_t)S * DFF);
    float* Ub = take((size_t)S * DFF);
    float* y = take((size_t)S * D);
    float* x1 = take((size_t)S * D);
    float* zb = take((size_t)S * INW);
    float* cb = take((size_t)S * 8);
    float* la = take((size_t)S * 256);
    float* omix = take((size_t)S * D);
    float* mn = take((size_t)ML * D);
    float* kvm = take((size_t)ML * 2048);
    auto gemm = [&](const float* A, int lda, const float* W, int ldw, float* C, int ldc, int M, int N, int K) {
        hipLaunchKernelGGL(gemm_f32, dim3((N + 63) / 64, M / 64), dim3(256), 0, stream, A, lda, W, ldw, C, ldc, M, N, K);
    };
    auto rms = [&](const float* inp, const float* g, const float* base, float alpha, float* o, int rows) {
        hipLaunchKernelGGL(rms_rows, dim3((rows + 3) / 4), dim3(256), 0, stream, inp, g, base, alpha, o, rows);
    };
    for (int b = 0; b < NB; ++b) {
        const float* xb = in[0] + (size_t)b * S * D;
        const float* memb = in[1] + (size_t)b * ML * D;
        float* ob = out + (size_t)b * S * D;
        rms(xb, in[2], nullptr, 0.f, xn, S);
        gemm(xn, D, in[3], DFF, Gb, DFF, S, DFF, D);
        gemm(xn, D, in[4], DFF, Ub, DFF, S, DFF, D);
        hipLaunchKernelGGL(swiglu_ew, dim3((unsigned)(((size_t)S * DFF + 255) / 256)), dim3(256), 0, stream, Gb, Ub, (size_t)S * DFF);
        gemm(Gb, DFF, in[5], D, y, D, S, D, DFF);
        rms(y, in[6], xb, 0.5f, x1, S);
        rms(x1, in[7], nullptr, 0.f, xn, S);
        gemm(xn, D, in[8], INW, zb, INW, S, INW, D);
        hipLaunchKernelGGL(fox_cumsum, dim3(1), dim3(64), 0, stream, zb, in[9], cb);
        hipLaunchKernelGGL(fox_attn, dim3(S / 64, 8), dim3(64), 0, stream, zb, cb, in[12], omix);
        hipLaunchKernelGGL(gla_gate, dim3(S), dim3(256), 0, stream, zb, in[10], in[11], la);
        hipLaunchKernelGGL(gla_rec, dim3(4), dim3(128), 0, stream, zb, la, in[13], omix);
        gemm(omix, D, in[14], D, y, D, S, D, D);
        rms(y, in[15], x1, 1.0f, x1, S);
        rms(x1, in[16], nullptr, 0.f, xn, S);
        gemm(xn, D, in[18], D, y, D, S, D, D);
        rms(memb, in[17], nullptr, 0.f, mn, ML);
        gemm(mn, D, in[19], 2048, kvm, 2048, ML, 2048, D);
        hipLaunchKernelGGL(mem_attn, dim3(S, 4), dim3(256), 0, stream, y, kvm, omix);
        gemm(omix, D, in[20], D, y, D, S, D, D);
        rms(y, in[21], x1, 1.0f, x1, S);
        rms(x1, in[22], nullptr, 0.f, xn, S);
        gemm(xn, D, in[23], DFF, Gb, DFF, S, DFF, D);
        gemm(xn, D, in[24], DFF, Ub, DFF, S, DFF, D);
        hipLaunchKernelGGL(swiglu_ew, dim3((unsigned)(((size_t)S * DFF + 255) / 256)), dim3(256), 0, stream, Gb, Ub, (size_t)S * DFF);
        gemm(Gb, DFF, in[25], D, y, D, S, D, DFF);
        rms(y, in[26], x1, 0.5f, x1, S);
        rms(x1, in[27], nullptr, 0.f, ob, S);
    }
}
```

```cpp
#include <hip/hip_runtime.h>
#include <hip/hip_cooperative_groups.h>
#include <hip/hip_bf16.h>
#include <cstdio>
#include <cstdint>
#include <cmath>
namespace pg8 {
#define PG8_LAS __attribute__((address_space(3)))
typedef unsigned short bf16_t;
typedef short bf16x8 __attribute__((ext_vector_type(8)));
typedef float f32x4 __attribute__((ext_vector_type(4)));
typedef unsigned u32x4 __attribute__((ext_vector_type(4)));
constexpr int BM = 256, BK = 64, HALF = 128, HTB = HALF * BK * 2  , STAGE_BYTES = 8 * HTB, NXCD = 8, WGM = 8;

__host__ __device__ __forceinline__ int lds_byte(int r, int c) { const int st = (r >> 4) * 2 + (c >> 5), rr = r & 15, cc = c & 31, ob = rr * 64 + cc * 2; return st * 1024 + (ob ^ (((ob >> 9) & 1) << 5)); }
__host__ __device__ __forceinline__ void stage_rc(int b, int& R, int& C) { const int st = b / 1024, sb = b % 1024, swz = sb ^ (((sb >> 9) & 1) << 5); R = (st >> 1) * 16 + swz / 64; C = (st & 1) * 32 + (swz % 64) / 2; }
__host__ __device__ __forceinline__ int perm32(int rho) { const int n = rho >> 4, i = rho & 15; return 8 * (i >> 2) + 4 * n + (i & 3); }

struct Unit { int pm, pn; long aoff, boff; };
struct Gemm { const bf16_t* A; const bf16_t* Bt; int lda, ldb, K; int kstepA = 0; int kstepB = 0; };

struct StaticOrder {
    int nM, nN, nwg, G, c, lda, ldb; long apanel = 0; long bpanel = 0; long bbatch = 0;
    __host__ __device__ void init(int M, int N, int G_, int c_, int lda_, int ldb_) { nM = M / BM; nN = N / BM; nwg = nM * nN; G = G_; c = c_; lda = lda_; ldb = ldb_; }
    __host__ __device__ bool next(int i, Unit& u) const {
        const long L = (long)i * G + c; if (L >= nwg) return false;
        int wgid = (int)L; { const int q = nwg / NXCD, r = nwg % NXCD, xcd = wgid % NXCD, off = wgid / NXCD; wgid = (xcd < r ? xcd * (q + 1) : r * (q + 1) + (xcd - r) * q) + off; }
        const int nig = WGM * nN, gid = wgid / nig, fm = gid * WGM, gsz = (nM - fm) < WGM ? (nM - fm) : WGM;
        u.pm = fm + ((wgid % nig) % gsz); u.pn = (wgid % nig) / gsz; u.aoff = apanel ? (long)u.pm * apanel : (long)u.pm * BM * lda; u.boff = (bpanel ? (long)u.pn * bpanel : (long)u.pn * BM * ldb) + (long)(u.pm >> 4) * bbatch; return true;
    }
    __device__ __forceinline__ void a_ready(const Unit&) const {}
    __device__ __forceinline__ void done(const Unit&) const {}
};

__device__ __forceinline__ unsigned cvt_pk_bf16(float lo, float hi) { unsigned r; asm volatile("v_cvt_pk_bf16_f32 %0, %1, %2" : "=v"(r) : "v"(lo), "v"(hi)); return r; }
typedef float f32x2 __attribute__((ext_vector_type(2)));
__device__ __forceinline__ f32x2 gelu_pk(f32x2 v) {
    const f32x2 av = __builtin_elementwise_abs(v), d = av * 0.2316418882f + 1.0f;
    f32x2 t; t.x = __builtin_amdgcn_rcpf(d.x); t.y = __builtin_amdgcn_rcpf(d.y);
    f32x2 q = t * 0.5307027145f + (-0.7265760135f); q = q * t + 0.7107068705f; q = q * t + (-0.142248368f); q = q * t + 0.127414796f; q = q * t;
    const f32x2 s = (v * v) * (-0.72134752044f);
    f32x2 e; e.x = __builtin_amdgcn_exp2f(s.x); e.y = __builtin_amdgcn_exp2f(s.y);
    const f32x2 m = v * (q * e), r = v - m;
    f32x2 o; o.x = v.x < 0.f ? m.x : r.x; o.y = v.y < 0.f ? m.y : r.y; return o;
}

template <int ACT  > struct EpiBf16 {
    static constexpr bool PERM = true, AFTER_DRAIN = false; static_assert(ACT == 0 || ACT == 1, "EpiBf16: ACT is 0 (none) or 1 (gelu_pk)");
    bf16_t* O; int ldc; const float* bias; int split_cols; size_t split_stride; float scale0;
    __device__ __forceinline__ void operator()(const f32x4 (&acc)[2][2][4][2], const Unit& u, int wr, int wc, int fr, int fq) const {
        const int row0 = u.pm * BM + wr * 64 + fr; int colt = u.pn * BM; bf16_t* base = O;
        float sc = 1.f; if (split_cols) { const int t = colt / split_cols; base += (size_t)t * split_stride; colt -= t * split_cols; if (t == 0) sc = scale0; }
        const int col0 = colt + wc * 32 + 8 * fq, bcol0 = u.pn * BM + wc * 32 + 8 * fq;
        f32x4 bv[2][2];
#pragma unroll
        for (int bj = 0; bj < 2; ++bj)
#pragma unroll
            for (int n = 0; n < 2; ++n) bv[bj][n] = bias ? *(const f32x4*)(bias + bcol0 + bj * HALF + 4 * n) : (f32x4){0.f, 0.f, 0.f, 0.f};
#pragma unroll
        for (int ai = 0; ai < 2; ++ai)
#pragma unroll
            for (int m = 0; m < 4; ++m) { bf16_t* rowp = base + (size_t)(row0 + ai * HALF + m * 16) * ldc + col0;
#pragma unroll
                for (int bj = 0; bj < 2; ++bj) { f32x4 v0 = acc[ai][bj][m][0] + bv[bj][0], v1 = acc[ai][bj][m][1] + bv[bj][1];
                    if (ACT == 1) { f32x2 a = gelu_pk((f32x2){v0[0], v0[1]}), b = gelu_pk((f32x2){v0[2], v0[3]}), c = gelu_pk((f32x2){v1[0], v1[1]}), d = gelu_pk((f32x2){v1[2], v1[3]});
                        v0 = (f32x4){a.x, a.y, b.x, b.y}; v1 = (f32x4){c.x, c.y, d.x, d.y}; }
                    v0 = v0 * sc; v1 = v1 * sc; u32x4 w; w.x = cvt_pk_bf16(v0[0], v0[1]); w.y = cvt_pk_bf16(v0[2], v0[3]); w.z = cvt_pk_bf16(v1[0], v1[1]); w.w = cvt_pk_bf16(v1[2], v1[3]);
                    *(u32x4*)(rowp + bj * HALF) = w; } }
    }
};

struct PanelStats {
    unsigned* xbuf;
    unsigned* cnt;
    unsigned* tmo;
    int ntn; float eps;
    unsigned code;
    __device__ __forceinline__ bool run(const f32x4 (&v)[2][2][4][2], const Unit& u, int wr, int wc, int fr, int fq, PG8_LAS unsigned char* lds, int wid, int lane) const {
        typedef float f32x2v __attribute__((ext_vector_type(2)));
        PG8_LAS f32x2v* P = (PG8_LAS f32x2v*)lds;
        PG8_LAS f32x2v* S = (PG8_LAS f32x2v*)(lds + 8192);
        PG8_LAS unsigned* flag = (PG8_LAS unsigned*)(lds + 8192 + 2048);
#pragma unroll
        for (int ai = 0; ai < 2; ++ai)
#pragma unroll
            for (int m = 0; m < 4; ++m) {
                float s = 0.f;
#pragma unroll
                for (int bj = 0; bj < 2; ++bj)
#pragma unroll
                    for (int n = 0; n < 2; ++n) { const f32x4 x = v[ai][bj][m][n]; s += (x[0] + x[1]) + (x[2] + x[3]); }
                s += __shfl_xor(s, 16); s += __shfl_xor(s, 32);
                const float mw = s * (1.0f / 64.0f); float q = 0.f;
#pragma unroll
                for (int bj = 0; bj < 2; ++bj)
#pragma unroll
                    for (int n = 0; n < 2; ++n) { const f32x4 d = v[ai][bj][m][n] - mw; q += (d[0] * d[0] + d[1] * d[1]) + (d[2] * d[2] + d[3] * d[3]); }
                q += __shfl_xor(q, 16); q += __shfl_xor(q, 32);
                if (fq == 0) P[(ai * HALF + wr * 64 + m * 16 + fr) * 4 + wc] = (f32x2v){mw, q};
            }
        asm volatile("s_waitcnt lgkmcnt(0)" ::: "memory"); __builtin_amdgcn_s_barrier(); asm volatile("" ::: "memory");
#if defined(BROKEN_EXCHANGE_NO_WAIT)
#warning BROKEN CONTROL BUILD: the row-statistics exchange does not wait; results are wrong by design
        if (blockIdx.x >= 64) { const long long t0_ = clock64(); while (clock64() - t0_ < 60000) __builtin_amdgcn_s_sleep(8); }
#endif
        const int row = wid * 32 + (lane & 31);
        if (lane < 32) {
            const f32x2v a = P[row * 4 + 0], b = P[row * 4 + 1], c = P[row * 4 + 2], d = P[row * 4 + 3];
            const float mt = (a.x + b.x + c.x + d.x) * 0.25f;
            const float da = a.x - mt, db = b.x - mt, dc = c.x - mt, dd = d.x - mt;
            const float m2 = (a.y + b.y) + (c.y + d.y) + 64.0f * ((da * da + db * db) + (dc * dc + dd * dd));
            unsigned long long* slot = (unsigned long long*)xbuf + ((size_t)(u.pm * BM + row) * 4 + u.pn);
            __hip_atomic_store(slot, ((unsigned long long)__float_as_uint(m2) << 32) | __float_as_uint(mt), __ATOMIC_RELAXED, __HIP_MEMORY_SCOPE_AGENT);
        }
        asm volatile("s_waitcnt vmcnt(0)" ::: "memory");
        if (lane == 0) __hip_atomic_fetch_add(cnt + 64 * u.pm, 1u, __ATOMIC_RELAXED, __HIP_MEMORY_SCOPE_AGENT);
        if (wid == 0) {
            bool dead = false; const unsigned long long t0 = __builtin_amdgcn_s_memrealtime(); const unsigned want = 8u * (unsigned)ntn;
            for (;;) {
#if defined(BROKEN_EXCHANGE_NO_WAIT)
                break;
#endif
                if ((unsigned)__builtin_amdgcn_readfirstlane(__hip_atomic_load(cnt + 64 * u.pm, __ATOMIC_RELAXED, __HIP_MEMORY_SCOPE_AGENT)) >= want) break;
                if (__builtin_amdgcn_s_memrealtime() - t0 > 2000000ull) {
                    if (lane == 0) { unsigned expect = 0u; __hip_atomic_compare_exchange_strong(tmo + 1, &expect, code | (unsigned)(u.pm & 0xff), __ATOMIC_RELAXED, __ATOMIC_RELAXED, __HIP_MEMORY_SCOPE_AGENT);
                                     __hip_atomic_store(tmo, 1u, __ATOMIC_RELAXED, __HIP_MEMORY_SCOPE_AGENT); }
                    dead = true; break; }
                __builtin_amdgcn_s_sleep(2);
            }
            __builtin_amdgcn_fence(__ATOMIC_ACQUIRE, "agent");
            if (lane == 0) flag[0] = dead ? 1u : 0u;
        }
        asm volatile("s_waitcnt vmcnt(0) lgkmcnt(0)" ::: "memory"); __builtin_amdgcn_s_barrier(); asm volatile("" ::: "memory");
        const bool bad = flag[0] != 0u;
        if (lane < 32) {
            const unsigned long long* slot = (const unsigned long long*)xbuf + (size_t)(u.pm * BM + row) * 4; float mt[4], m2[4]; float ms = 0.f;
#pragma unroll
            for (int t = 0; t < 4; ++t) { if (t < ntn) { const unsigned long long w = __hip_atomic_load(slot + t, __ATOMIC_RELAXED, __HIP_MEMORY_SCOPE_AGENT); mt[t] = __uint_as_float((unsigned)w); m2[t] = __uint_as_float((unsigned)(w >> 32)); } else { mt[t] = 0.f; m2[t] = 0.f; } ms += mt[t]; }
            const float mean = ms / (float)ntn; float q = 0.f;
#pragma unroll
            for (int t = 0; t < 4; ++t) if (t < ntn) { const float dm = mt[t] - mean; q += m2[t] + 256.0f * dm * dm; }
            S[row] = (f32x2v){mean, 1.0f / sqrtf(q / (256.0f * (float)ntn) + eps)};
        }
        asm volatile("s_waitcnt lgkmcnt(0)" ::: "memory"); __builtin_amdgcn_s_barrier(); asm volatile("" ::: "memory");
        return bad;
    }
};
struct EpiLnRes {
    static constexpr bool PERM = false, AFTER_DRAIN = true;
    const float* base; float* out; int ldc; const float* bias; PanelStats st; unsigned poison;
    __device__ __forceinline__ void fused(f32x4 (&acc)[2][2][4][2], const Unit& u, int wr, int wc, int fr, int fq, PG8_LAS unsigned char* lds, int wid, int lane) const {
        typedef float f32x2v __attribute__((ext_vector_type(2)));
        const PG8_LAS f32x2v* S = (const PG8_LAS f32x2v*)(lds + 8192);
        const int col0 = u.pn * BM + wc * 32 + 4 * fq;
#pragma unroll
        for (int bj = 0; bj < 2; ++bj)
#pragma unroll
            for (int n = 0; n < 2; ++n) { const f32x4 bv = bias ? *(const f32x4*)(bias + col0 + bj * HALF + n * 16) : (f32x4){0.f, 0.f, 0.f, 0.f};
#pragma unroll
                for (int ai = 0; ai < 2; ++ai)
#pragma unroll
                    for (int m = 0; m < 4; ++m) acc[ai][bj][m][n] += bv; }
        f32x4 pre[4][2][2];
#pragma unroll
        for (int m = 0; m < 4; ++m) { const size_t off = (size_t)(u.pm * BM + wr * 64 + m * 16 + fr) * ldc + col0;
#pragma unroll
            for (int bj = 0; bj < 2; ++bj)
#pragma unroll
                for (int n = 0; n < 2; ++n) pre[m][bj][n] = *(const f32x4*)(base + off + bj * HALF + n * 16); }
        const bool bad = st.run(acc, u, wr, wc, fr, fq, lds, wid, lane) || poison != 0u;
        const float qnan = __builtin_nanf("");
#pragma unroll
        for (int ai = 0; ai < 2; ++ai)
#pragma unroll
            for (int m = 0; m < 4; ++m) { const int r = ai * HALF + wr * 64 + m * 16 + fr; const f32x2v sr = S[r]; const size_t off = (size_t)(u.pm * BM + r) * ldc + col0;
#pragma unroll
                for (int bj = 0; bj < 2; ++bj)
#pragma unroll
                    for (int n = 0; n < 2; ++n) { const f32x4 bs = ai == 0 ? pre[m][bj][n] : *(const f32x4*)(base + off + bj * HALF + n * 16); f32x4 o = bs + (acc[ai][bj][m][n] - sr.x) * sr.y;
                        if (bad) o = (f32x4){qnan, qnan, qnan, qnan}; *(f32x4*)(out + off + bj * HALF + n * 16) = o; }
                if (m & 1) asm volatile("" ::: "memory"); }
    }
};
struct EpiLnResLn {
    static constexpr bool PERM = false, AFTER_DRAIN = true;
    const float* base; float* out; bf16_t* xn; int ldc; const float* bias; PanelStats st1, st2; unsigned poison;
    __device__ __forceinline__ void fused(f32x4 (&acc)[2][2][4][2], const Unit& u, int wr, int wc, int fr, int fq, PG8_LAS unsigned char* lds, int wid, int lane) const {
        typedef float f32x2v __attribute__((ext_vector_type(2))); typedef unsigned u32x2v __attribute__((ext_vector_type(2)));
        const PG8_LAS f32x2v* S = (const PG8_LAS f32x2v*)(lds + 8192);
        const int col0 = u.pn * BM + wc * 32 + 4 * fq;
#pragma unroll
        for (int bj = 0; bj < 2; ++bj)
#pragma unroll
            for (int n = 0; n < 2; ++n) { const f32x4 bv = bias ? *(const f32x4*)(bias + col0 + bj * HALF + n * 16) : (f32x4){0.f, 0.f, 0.f, 0.f};
#pragma unroll
                for (int ai = 0; ai < 2; ++ai)
#pragma unroll
                    for (int m = 0; m < 4; ++m) acc[ai][bj][m][n] += bv; }
        bool bad = st1.run(acc, u, wr, wc, fr, fq, lds, wid, lane) || poison != 0u;
        const float qnan = __builtin_nanf("");
#pragma unroll
        for (int ai = 0; ai < 2; ++ai)
#pragma unroll
            for (int m = 0; m < 4; ++m) { const int r = ai * HALF + wr * 64 + m * 16 + fr; const f32x2v sr = S[r]; const size_t off = (size_t)(u.pm * BM + r) * ldc + col0;
#pragma unroll
                for (int bj = 0; bj < 2; ++bj)
#pragma unroll
                    for (int n = 0; n < 2; ++n) { const f32x4 bs = *(const f32x4*)(base + off + bj * HALF + n * 16); acc[ai][bj][m][n] = bs + (acc[ai][bj][m][n] - sr.x) * sr.y; }
                asm volatile("" : "+v"(acc[ai][0][m][0]), "+v"(acc[ai][0][m][1]), "+v"(acc[ai][1][m][0]), "+v"(acc[ai][1][m][1]));
                if (m & 1) asm volatile("" ::: "memory"); }
        const bool bad1 = bad;
        bad = st2.run(acc, u, wr, wc, fr, fq, lds, wid, lane) || bad;
#pragma unroll
        for (int ai = 0; ai < 2; ++ai)
#pragma unroll
            for (int m = 0; m < 4; ++m) { const int r = ai * HALF + wr * 64 + m * 16 + fr; const f32x2v sr = S[r]; const size_t off = (size_t)(u.pm * BM + r) * ldc + col0;
#pragma unroll
                for (int bj = 0; bj < 2; ++bj)
#pragma unroll
                    for (int n = 0; n < 2; ++n) { const f32x4 x1 = acc[ai][bj][m][n]; *(f32x4*)(out + off + bj * HALF + n * 16) = bad1 ? (f32x4){qnan, qnan, qnan, qnan} : x1;
                        const f32x4 o = (x1 - sr.x) * sr.y; u32x2v w; w.x = cvt_pk_bf16(o[0], o[1]); w.y = cvt_pk_bf16(o[2], o[3]);
                        if (bad) { w.x = 0x7fc07fc0u; w.y = 0x7fc07fc0u; } *(u32x2v*)(xn + off + bj * HALF + n * 16) = w; }
                asm volatile("" ::: "memory"); }
    }
};

template <class Epi, class Sched, bool ALIGN_EPI = false, bool SP2 = false>
__device__ __forceinline__ void gemm_phase(PG8_LAS unsigned char* lds, const Gemm g, const Sched& S, const Epi& E) {
    const int tid = threadIdx.x, wid = __builtin_amdgcn_readfirstlane(tid >> 6), lane = tid & 63, wr = wid >> 2, wc = wid & 3, fr = lane & 15, fq = lane >> 4;
    const int K = g.K, nt = K / BK;
    unsigned voffA[2], voffB[2];
#pragma unroll
    for (int i = 0; i < 2; ++i) { int R, C; stage_rc(tid * 16 + i * 8192, R, C); const int Rb = Epi::PERM ? ((R & ~31) + perm32(R & 31)) : R;
        voffA[i] = (unsigned)(R * g.lda + C) * 2u; voffB[i] = (unsigned)(Rb * g.ldb + C) * 2u; }
    const size_t kstepB = g.kstepB ? (size_t)g.kstepB : (size_t)(BK * 2), kstepA = g.kstepA ? (size_t)g.kstepA : (size_t)(BK * 2);
    const size_t hstepA = (size_t)HALF * g.lda * 2, hstepB = (size_t)HALF * g.ldb * 2;
    const unsigned ldsw = (unsigned)wid * 1024u;
    const int aoff = lds_byte(wr * 64 + fr, fq * 8), boff = lds_byte(wc * 32 + fr, fq * 8);
#define PG8_SA(b, h) (((b) * 2 + (h)) * HTB)
#define PG8_SB(b, h) ((4 + (b) * 2 + (h)) * HTB)
#define PG8_STAGE(bufoff, gbase, voff) do { _Pragma("unroll") for (int _i = 0; _i < 2; ++_i) \
        __builtin_amdgcn_global_load_lds((const unsigned*)((const char*)(gbase) + (voff)[_i]), (PG8_LAS unsigned*)(lds + (bufoff) + ldsw + _i * 8192), 16, 0, 0); } while (0)
#define PG8_LDA(dst, b, h) do { _Pragma("unroll") for (int m = 0; m < 4; ++m) _Pragma("unroll") for (int k = 0; k < 2; ++k) dst[m][k] = *(const PG8_LAS bf16x8*)(lds + PG8_SA(b, h) + aoff + m * 2048 + k * 1024); } while (0)
#define PG8_LDB(dst, b, h) do { _Pragma("unroll") for (int n = 0; n < 2; ++n) _Pragma("unroll") for (int k = 0; k < 2; ++k) dst[n][k] = *(const PG8_LAS bf16x8*)(lds + PG8_SB(b, h) + boff + n * 2048 + k * 1024); } while (0)
#define PG8_MMA(ai, bj, At, Bt) do { __builtin_amdgcn_s_setprio(1); _Pragma("unroll") for (int m = 0; m < 4; ++m) _Pragma("unroll") for (int n = 0; n < 2; ++n) _Pragma("unroll") for (int k = 0; k < 2; ++k) \
        acc[ai][bj][m][n] = __builtin_amdgcn_mfma_f32_16x16x32_bf16(Bt[n][k], At[m][k], acc[ai][bj][m][n], 0, 0, 0); __builtin_amdgcn_s_setprio(0); } while (0)
#define PG8_WAIT_V(n) asm volatile("s_waitcnt vmcnt(" #n ")" ::: "memory")
#define PG8_WAIT_L(n) asm volatile("s_waitcnt lgkmcnt(" #n ")" ::: "memory")
#define PG8_BAR __builtin_amdgcn_s_barrier()
#define PG8_SCHED __builtin_amdgcn_sched_barrier(0)
    Unit cur, nxt; int ui = 0;
    if (!S.next(0, cur)) return;
    f32x4 acc[2][2][4][2];
#pragma unroll
    for (int a = 0; a < 2; ++a)
#pragma unroll
        for (int b = 0; b < 2; ++b)
#pragma unroll
            for (int m = 0; m < 4; ++m)
#pragma unroll
                for (int n = 0; n < 2; ++n) acc[a][b][m][n] = (f32x4){0.f, 0.f, 0.f, 0.f};
    bf16x8 At[4][2], B0[2][2], B1[2][2];
    const char* cA = (const char*)(g.A + cur.aoff); const char* cB = (const char*)(g.Bt + cur.boff);
    S.a_ready(cur);
    if constexpr (SP2) {
        PG8_STAGE(PG8_SB(0, 0), cB, voffB); PG8_STAGE(PG8_SB(0, 1), cB + hstepB, voffB); PG8_STAGE(PG8_SA(0, 0), cA, voffA); PG8_STAGE(PG8_SA(0, 1), cA + hstepA, voffA);
        if (wr == 1) PG8_BAR;
        PG8_WAIT_V(2); PG8_BAR;
        PG8_STAGE(PG8_SB(1, 0), cB + kstepB, voffB); PG8_STAGE(PG8_SA(1, 0), cA + kstepA, voffA); PG8_STAGE(PG8_SB(1, 1), cB + hstepB + kstepB, voffB);
        PG8_WAIT_V(6); PG8_BAR;
    } else {
        PG8_STAGE(PG8_SB(0, 0), cB, voffB); PG8_STAGE(PG8_SA(0, 0), cA, voffA); PG8_STAGE(PG8_SB(0, 1), cB + hstepB, voffB); PG8_STAGE(PG8_SA(0, 1), cA + hstepA, voffA);
        if (wr == 1) PG8_BAR;
        PG8_WAIT_V(4); PG8_BAR;
        PG8_STAGE(PG8_SB(1, 0), cB + kstepB, voffB); PG8_STAGE(PG8_SA(1, 0), cA + kstepA, voffA); PG8_STAGE(PG8_SB(1, 1), cB + hstepB + kstepB, voffB);
        PG8_WAIT_V(6); PG8_BAR;
    }
    for (;;) {
        const bool has_next = S.next(ui + 1, nxt);
        const char* nA = has_next ? (const char*)(g.A + nxt.aoff) : cA; const char* nB = has_next ? (const char*)(g.Bt + nxt.boff) : cB;
        for (int t = 0; t < nt; t += 2) {
            const bool last = (t == nt - 2);
            const char* a1 = cA + (size_t)(t + 1) * kstepA;
            const char* a2 = last ? nA : cA + (size_t)(t + 2) * kstepA; const char* b2 = last ? nB : cB + (size_t)(t + 2) * kstepB;
            const char* a3 = a2 + kstepA; const char* b3 = b2 + kstepB;
            if (last && has_next) S.a_ready(nxt);
            if constexpr (SP2) {
            PG8_LDB(B0, 0, 0); PG8_LDB(B1, 0, 1); PG8_SCHED; PG8_LDA(At, 0, 0); PG8_STAGE(PG8_SA(1, 1), a1 + hstepA, voffA);
            PG8_WAIT_V(8); PG8_WAIT_L(0); PG8_BAR; PG8_MMA(0, 0, At, B0); PG8_MMA(0, 1, At, B1); PG8_BAR; PG8_SCHED;
            PG8_LDA(At, 0, 1); PG8_STAGE(PG8_SB(0, 0), b2, voffB); PG8_STAGE(PG8_SB(0, 1), b2 + hstepB, voffB); PG8_STAGE(PG8_SA(0, 0), a2, voffA);
            PG8_WAIT_V(8); PG8_WAIT_L(0); PG8_BAR; PG8_MMA(1, 0, At, B0); PG8_MMA(1, 1, At, B1); PG8_BAR; PG8_SCHED;
            PG8_LDB(B0, 1, 0); PG8_LDB(B1, 1, 1); PG8_SCHED; PG8_LDA(At, 1, 0); PG8_STAGE(PG8_SA(0, 1), a2 + hstepA, voffA);
            PG8_WAIT_V(8); PG8_WAIT_L(0); PG8_BAR; PG8_MMA(0, 0, At, B0); PG8_MMA(0, 1, At, B1); PG8_BAR; PG8_SCHED;
            PG8_LDA(At, 1, 1); PG8_STAGE(PG8_SB(1, 0), b3, voffB); PG8_STAGE(PG8_SB(1, 1), b3 + hstepB, voffB); PG8_STAGE(PG8_SA(1, 0), a3, voffA);
            PG8_WAIT_V(8); PG8_WAIT_L(0); PG8_BAR; PG8_MMA(1, 0, At, B0); PG8_MMA(1, 1, At, B1); PG8_BAR; PG8_SCHED;
            } else {
            PG8_LDB(B0, 0, 0); PG8_SCHED; PG8_LDA(At, 0, 0); PG8_STAGE(PG8_SA(1, 1), a1 + hstepA, voffA);
            PG8_WAIT_L(8); PG8_BAR; PG8_WAIT_L(0); PG8_MMA(0, 0, At, B0); PG8_BAR; PG8_SCHED;
            PG8_LDB(B1, 0, 1); PG8_STAGE(PG8_SB(0, 0), b2, voffB);
            PG8_BAR; PG8_WAIT_L(0); PG8_MMA(0, 1, At, B1); PG8_BAR;
            PG8_LDA(At, 0, 1); PG8_STAGE(PG8_SA(0, 0), a2, voffA);
            PG8_BAR; PG8_WAIT_L(0); PG8_MMA(1, 0, At, B0); PG8_BAR; PG8_SCHED;
            PG8_STAGE(PG8_SB(0, 1), b2 + hstepB, voffB);
            PG8_WAIT_V(6); PG8_BAR; PG8_MMA(1, 1, At, B1); PG8_BAR;
            PG8_LDB(B0, 1, 0); PG8_SCHED; PG8_LDA(At, 1, 0); PG8_STAGE(PG8_SA(0, 1), a2 + hstepA, voffA);
            PG8_WAIT_L(8); PG8_BAR; PG8_WAIT_L(0); PG8_MMA(0, 0, At, B0); PG8_BAR; PG8_SCHED;
            PG8_LDB(B1, 1, 1); PG8_STAGE(PG8_SB(1, 0), b3, voffB);
            PG8_BAR; PG8_WAIT_L(0); PG8_MMA(0, 1, At, B1); PG8_BAR;
            PG8_LDA(At, 1, 1); PG8_STAGE(PG8_SA(1, 0), a3, voffA);
            PG8_BAR; PG8_WAIT_L(0); PG8_MMA(1, 0, At, B0); PG8_BAR; PG8_SCHED;
            PG8_STAGE(PG8_SB(1, 1), b3 + hstepB, voffB);
            PG8_WAIT_V(6); PG8_BAR; PG8_MMA(1, 1, At, B1); PG8_BAR;
            }
        }
        if constexpr (ALIGN_EPI) { if (wr == 0) PG8_BAR; }
        if constexpr (!Epi::AFTER_DRAIN) { E(acc, cur, wr, wc, fr, fq); S.done(cur); }
        if (!has_next) break;
#pragma unroll
        for (int a = 0; a < 2; ++a)
#pragma unroll
            for (int b = 0; b < 2; ++b)
#pragma unroll
                for (int m = 0; m < 4; ++m)
#pragma unroll
                    for (int n = 0; n < 2; ++n) acc[a][b][m][n] = (f32x4){0.f, 0.f, 0.f, 0.f};
        cur = nxt; cA = nA; cB = nB; ++ui;
        if constexpr (ALIGN_EPI) { if (wr == 1) PG8_BAR; }
    }
    PG8_WAIT_V(0);
    if constexpr (!ALIGN_EPI) { if (wr == 0) PG8_BAR; }
    PG8_BAR;
    if constexpr (Epi::AFTER_DRAIN) { E.fused(acc, cur, wr, wc, fr, fq, lds, wid, lane); S.done(cur); }
#undef PG8_SA
#undef PG8_SB
#undef PG8_STAGE
#undef PG8_LDA
#undef PG8_LDB
#undef PG8_MMA
#undef PG8_WAIT_V
#undef PG8_WAIT_L
#undef PG8_BAR
#undef PG8_SCHED
}
}
namespace pg8 {
struct EpiSwiGLU {
    static constexpr bool PERM = true, AFTER_DRAIN = false;
    bf16_t* O; int nkt;
    __device__ __forceinline__ void operator()(const f32x4 (&acc)[2][2][4][2], const Unit& u, int wr, int wc, int fr, int fq) const {
        bf16_t* base = O + ((size_t)(u.pm * nkt + 2 * u.pn + (wc >> 1)) * 256 + wr * 64 + fr) * 64 + 32 * (wc & 1) + 8 * fq;
#pragma unroll
        for (int ai = 0; ai < 2; ++ai)
#pragma unroll
            for (int m = 0; m < 4; ++m) {
                float h[8];
#pragma unroll
                for (int n = 0; n < 2; ++n)
#pragma unroll
                    for (int i = 0; i < 4; ++i) { const float g = acc[ai][0][m][n][i], up = acc[ai][1][m][n][i];
                        h[n * 4 + i] = g * __builtin_amdgcn_rcpf(1.0f + __builtin_amdgcn_exp2f(-1.4426950408889634f * g)) * up; }
                u32x4 w; w.x = cvt_pk_bf16(h[0], h[1]); w.y = cvt_pk_bf16(h[2], h[3]); w.z = cvt_pk_bf16(h[4], h[5]); w.w = cvt_pk_bf16(h[6], h[7]);
                *(u32x4*)(base + (size_t)(ai * HALF + m * 16) * 64) = w;
            }
    }
};
struct EpiF32 {
    static constexpr bool PERM = false, AFTER_DRAIN = false;
    float* O; int ldc;
    __device__ __forceinline__ void operator()(const f32x4 (&acc)[2][2][4][2], const Unit& u, int wr, int wc, int fr, int fq) const {
        const int row0 = u.pm * BM + wr * 64 + fr, col0 = u.pn * BM + wc * 32 + 4 * fq;
#pragma unroll
        for (int ai = 0; ai < 2; ++ai)
#pragma unroll
            for (int m = 0; m < 4; ++m) { float* rowp = O + (size_t)(row0 + ai * HALF + m * 16) * ldc + col0;
#pragma unroll
                for (int bj = 0; bj < 2; ++bj)
#pragma unroll
                    for (int n = 0; n < 2; ++n) *(f32x4*)(rowp + bj * HALF + n * 16) = acc[ai][bj][m][n]; }
    }
};
struct EpiSoftmax {
    static constexpr bool PERM = true, AFTER_DRAIN = false;
    bf16_t* O; int ldc; PG8_LAS float* tab;
    __device__ __forceinline__ void operator()(f32x4 (&acc)[2][2][4][2], const Unit& u, int wr, int wc, int fr, int fq) const {
#pragma unroll
        for (int ai = 0; ai < 2; ++ai)
#pragma unroll
            for (int m = 0; m < 4; ++m) { float s = 0.f;
#pragma unroll
                for (int bj = 0; bj < 2; ++bj)
#pragma unroll
                    for (int n = 0; n < 2; ++n) { f32x4 p; p[0] = __builtin_amdgcn_exp2f(acc[ai][bj][m][n][0]); p[1] = __builtin_amdgcn_exp2f(acc[ai][bj][m][n][1]);
                        p[2] = __builtin_amdgcn_exp2f(acc[ai][bj][m][n][2]); p[3] = __builtin_amdgcn_exp2f(acc[ai][bj][m][n][3]); acc[ai][bj][m][n] = p; s += (p[0] + p[1]) + (p[2] + p[3]); }
                s += __shfl_xor(s, 16); s += __shfl_xor(s, 32);
                if (fq == 0) tab[(ai * HALF + wr * 64 + m * 16 + fr) * 4 + wc] = s; }
        asm volatile("s_waitcnt lgkmcnt(0)" ::: "memory"); __builtin_amdgcn_s_barrier(); asm volatile("" ::: "memory");
        const int row0 = u.pm * BM + wr * 64 + fr, col0 = u.pn * BM + wc * 32 + 8 * fq;
#pragma unroll
        for (int ai = 0; ai < 2; ++ai)
#pragma unroll
            for (int m = 0; m < 4; ++m) { const f32x4 t = *(const PG8_LAS f32x4*)(tab + (ai * HALF + wr * 64 + m * 16 + fr) * 4);
                const float inv = __builtin_amdgcn_rcpf((t[0] + t[1]) + (t[2] + t[3]));
                bf16_t* rowp = O + (size_t)(row0 + ai * HALF + m * 16) * ldc + col0;
#pragma unroll
                for (int bj = 0; bj < 2; ++bj) { const f32x4 v0 = acc[ai][bj][m][0] * inv, v1 = acc[ai][bj][m][1] * inv;
                    u32x4 w; w.x = cvt_pk_bf16(v0[0], v0[1]); w.y = cvt_pk_bf16(v0[2], v0[3]); w.z = cvt_pk_bf16(v1[0], v1[1]); w.w = cvt_pk_bf16(v1[2], v1[3]);
                    *(u32x4*)(rowp + bj * HALF) = w; } }
        asm volatile("s_waitcnt lgkmcnt(0)" ::: "memory"); __builtin_amdgcn_s_barrier(); asm volatile("" ::: "memory");
    }
};
}
constexpr int NWAVES = 8;
constexpr int NB = 8, SEQ = 4096, T = NB * SEQ, D = 1024, DFF = 2816, NGU = 2 * DFF, ZW = 3072, ML = 256, INW = 3096;
constexpr float RMS_EPS = 1e-6f;
constexpr float LOG2E = 1.4426950408889634f;
constexpr float C2 = 0.125f * LOG2E;
constexpr size_t MiB = 1u << 20;
constexpr size_t WS_CTL = 0, CTL_ZERO_BYTES = 1 * MiB;
constexpr size_t WS_WGU1 = 1 * MiB, WS_WD1 = 12 * MiB, WS_WGU2 = 18 * MiB, WS_WD2 = 29 * MiB, WS_WIN = 35 * MiB, WS_WSM = 41 * MiB, WS_WOUT = 42 * MiB,
                 WS_WQRM = 44 * MiB, WS_WKVT = 46 * MiB, WS_WOT = 50 * MiB, WS_MN = 52 * MiB, WS_KVM = 56 * MiB, WS_ZSM = 64 * MiB, WS_CLOC = 68 * MiB, WS_TOT = 69 * MiB;
constexpr size_t WS_XN = 72 * MiB, WS_BIG = 136 * MiB, WS_XNB = 328 * MiB, WS_Y = 392 * MiB, WS_END = 512 * MiB;
constexpr size_t WS_RINV = 70 * MiB;
constexpr size_t BIG_SLICE = 24 * MiB, SL_WQK = 8 * MiB, SL_VWOT = 10 * MiB, Y_SLICE = 8 * MiB;
constexpr int RING_OFF = 0, RING_BYTES = 131072, LDSCTL_OFF = RING_BYTES, MISC_OFF = LDSCTL_OFF + 320, LDS_BYTES = 147456;
constexpr int TAB_OFF = RING_BYTES + 1024;

#define GAS __attribute__((address_space(1)))
#define LAS __attribute__((address_space(3)))
typedef unsigned short bf16;
typedef unsigned v4u __attribute__((ext_vector_type(4)));
typedef unsigned v2u __attribute__((ext_vector_type(2)));
typedef float f32x4 __attribute__((ext_vector_type(4)));
typedef short bf16x8 __attribute__((ext_vector_type(8)));
#define LDS_WAIT() asm volatile("s_waitcnt lgkmcnt(0)" ::: "memory")
#define VM_WAIT() asm volatile("s_waitcnt vmcnt(0)" ::: "memory")
__device__ __forceinline__ unsigned f2bf(float f) { unsigned u = __builtin_bit_cast(unsigned, f); return (u + 0x7fffu + ((u >> 16) & 1u)) >> 16; }
__device__ __forceinline__ unsigned pk2(float lo, float hi) { return f2bf(lo) | (f2bf(hi) << 16); }
__device__ __forceinline__ float wave_sum(float v) {
#pragma unroll
    for (int o = 1; o < 64; o <<= 1) v += __shfl_xor(v, o);
    return v;
}

typedef GAS unsigned gu32;
#define RLX_AGENT __ATOMIC_RELAXED, __HIP_MEMORY_SCOPE_AGENT
constexpr int CW_BAR = 4096;
#define XB_TMO      128
#define XB_XCNT(j)  (256  + 64 * (j))
#define XB_XSUB(j)  (1280 + 64 * (j))
#define XB_XGEN(j)  (2304 + 64 * (j))
#define XB_TOP      3328
#define XB_TOPGEN   3392
#define XCD_BAR_WORDS 3456
#define XB_SPIN_CAP (1u << 18)

__device__ __forceinline__ unsigned xb_ld(unsigned* p)              { return __hip_atomic_load(p, __ATOMIC_RELAXED, __HIP_MEMORY_SCOPE_AGENT); }
__device__ __forceinline__ unsigned xb_add(unsigned* p, unsigned v) { return __hip_atomic_fetch_add(p, v, __ATOMIC_RELAXED, __HIP_MEMORY_SCOPE_AGENT); }
__device__ __forceinline__ unsigned xb_xcc_id() { return (unsigned)__builtin_amdgcn_s_getreg((3 << 11) | 20) & 0xFu; }
#define XB_SPIN(cond, bar) do { unsigned _sp = 0; while (cond) { __builtin_amdgcn_s_sleep(1); \
    if ((++_sp & 255u) == 0u) { if (xb_ld(&(bar)[XB_TMO])) break; if (_sp > XB_SPIN_CAP) { atomicAdd(&(bar)[XB_TMO], 1u); break; } } } } while (0)

struct XcdBarrier {
    unsigned* bar; unsigned x;
    volatile LAS unsigned* st;
};

__device__ __forceinline__ XcdBarrier xcd_barrier_post(unsigned* bar, volatile LAS unsigned* st) {
    XcdBarrier b; b.bar = bar; b.x = xb_xcc_id(); b.st = st;
    if (threadIdx.x == 0) (void)xb_add(&bar[XB_XCNT(b.x)], 1u);
    return b;
}
__device__ __forceinline__ void xcd_barrier_complete(unsigned* bar, unsigned x, unsigned& nloc, unsigned& nx) {
    const unsigned G = gridDim.x * gridDim.y * gridDim.z;
    unsigned sum, cnt, mine, sp = 0u;
    for (;;) {
        sum = 0u; cnt = 0u; mine = 0u;
#pragma unroll
        for (unsigned j = 0; j < 16; ++j) { const unsigned c = xb_ld(&bar[XB_XCNT(j)]); sum += c; cnt += (c > 0u) ? 1u : 0u; mine = (j == x) ? c : mine; }
        if (sum == G) break;
        __builtin_amdgcn_s_sleep(1);
        if ((++sp & 255u) == 0u) { if (xb_ld(&bar[XB_TMO])) break; if (sp > XB_SPIN_CAP) { atomicAdd(&bar[XB_TMO], 1u); break; } }
    }
    nloc = mine > 0u ? mine : 1u; nx = cnt > 0u ? cnt : 1u;
}

__device__ __forceinline__ void xcd_barrier(const XcdBarrier& b) {
    asm volatile("s_waitcnt vmcnt(0)" ::: "memory");
    __syncthreads();
    if (threadIdx.x == 0) {
        unsigned* bar = b.bar;
        __builtin_amdgcn_s_waitcnt(0);
        unsigned nloc = b.st[0], nx = b.st[1];
        if (nloc == 0u) { xcd_barrier_complete(bar, b.x, nloc, nx); b.st[0] = nloc; b.st[1] = nx; }
        const unsigned old = xb_add(&bar[XB_XSUB(b.x)], 1u);
        const unsigned gen = old / nloc;
        if (old + 1u == (gen + 1u) * nloc) {
            __builtin_amdgcn_fence(__ATOMIC_RELEASE, "agent");
            asm volatile("s_waitcnt vmcnt(0)" ::: "memory");
            const unsigned og = xb_add(&bar[XB_TOP], 1u);
            const unsigned tg = og / nx;
            if (og + 1u == (tg + 1u) * nx) xb_add(&bar[XB_TOPGEN], 1u);
            else XB_SPIN(xb_ld(&bar[XB_TOPGEN]) == tg, bar);
            __builtin_amdgcn_fence(__ATOMIC_ACQUIRE, "agent");
            xb_add(&bar[XB_XGEN(b.x)], 1u);
            asm volatile("s_waitcnt vmcnt(0)" ::: "memory");
        } else {
            XB_SPIN(xb_ld(&bar[XB_XGEN(b.x)]) == gen, bar);
            __builtin_amdgcn_fence(__ATOMIC_ACQUIRE, "agent");
            asm volatile("s_waitcnt vmcnt(0)" ::: "memory");
        }
    }
    __syncthreads();
}

struct Frame {
    LAS unsigned char* lds;
    int tid, lane, wave, vcu, G;
    const float* const* in;
    const float* x; float* out; unsigned char* ws;
};
struct Args { const float* in[28]; float* out; unsigned char* ws; int ph_lo, ph_hi; };

struct SegC { int win, ldw, K, src0, ncols, dst0, il, gin; float cs; unsigned wsoff; int blk; };
__constant__ SegC SEGS[] = {
    {3, DFF, D, 0, DFF, 0, 1, 2, 1.f, (unsigned)WS_WGU1}, {4, DFF, D, 0, DFF, 128, 1, 2, 1.f, (unsigned)WS_WGU1}, {5, D, DFF, 0, D, 0, 0, -1, 1.f, (unsigned)WS_WD1, 1},
    {23, DFF, D, 0, DFF, 0, 1, 22, 1.f, (unsigned)WS_WGU2}, {24, DFF, D, 0, DFF, 128, 1, 22, 1.f, (unsigned)WS_WGU2}, {25, D, DFF, 0, D, 0, 0, -1, 1.f, (unsigned)WS_WD2, 1},
    {8, INW, D, 0, 512, 0, 0, 7, C2, (unsigned)WS_WIN}, {8, INW, D, 512, 512, 512, 0, 7, 1.f, (unsigned)WS_WIN}, {8, INW, D, 1024, 512, 1024, 0, 7, 1.f, (unsigned)WS_WIN},
    {8, INW, D, 1544, 256, 1536, 0, 7, 0.125f, (unsigned)WS_WIN}, {8, INW, D, 1800, 256, 1792, 0, 7, 1.f, (unsigned)WS_WIN}, {8, INW, D, 2056, 512, 2048, 0, 7, 1.f, (unsigned)WS_WIN},
    {8, INW, D, 2584, 512, 2560, 0, 7, 1.f, (unsigned)WS_WIN},
    {14, D, D, 0, D, 0, 0, -1, 1.f, (unsigned)WS_WOUT}, {19, 2048, D, 0, 2048, 0, 0, 17, 1.f, (unsigned)WS_WKVT}, {20, D, D, 0, D, 0, 0, -1, 1.f, (unsigned)WS_WOT},
};
constexpr int NSEG = 16;

__device__ __forceinline__ void tr_item(const float* W, int ldw, int k0, int ns0, int nvalid, bf16* WT, int ldk, int dst0, int il, const float* gk, float cs, int lane, int blk) {
    const int n = 4 * lane;
    if (n >= nvalid) return;
    const float* src = W + (size_t)k0 * ldw + ns0 + n;
#pragma unroll 2
    for (int kb = 0; kb < 8; ++kb) {
        f32x4 v[8];
#pragma unroll
        for (int j = 0; j < 8; ++j) v[j] = *(const f32x4*)(src + (size_t)(kb * 8 + j) * ldw);
        float sc[8];
#pragma unroll
        for (int j = 0; j < 8; ++j) sc[j] = gk ? cs * gk[k0 + kb * 8 + j] : cs;
#pragma unroll
        for (int i = 0; i < 4; ++i) { const int nn = n + i; const int dr = dst0 + (il ? (nn >> 7) * 256 + (nn & 127) : nn);
            v4u o; o.x = pk2(v[0][i] * sc[0], v[1][i] * sc[1]); o.y = pk2(v[2][i] * sc[2], v[3][i] * sc[3]); o.z = pk2(v[4][i] * sc[4], v[5][i] * sc[5]); o.w = pk2(v[6][i] * sc[6], v[7][i] * sc[7]);
            const size_t off = blk ? ((size_t)((dr >> 8) * (ldk >> 6) + ((k0 + kb * 8) >> 6)) * 16384 + (size_t)(dr & 255) * 64 + ((k0 + kb * 8) & 63)) : ((size_t)dr * ldk + k0 + kb * 8);
            *(GAS v4u*)(WT + off) = o; }
    }
}
__device__ __forceinline__ void rms_row_to_bf16(const float* xrow, bf16* orow, int lane, float* rinv = nullptr) {
    const GAS f32x4* xr = (const GAS f32x4*)xrow + lane;
    f32x4 v[4]; float s = 0.f;
#pragma unroll
    for (int j = 0; j < 4; ++j) { v[j] = xr[64 * j]; s += (v[j].x * v[j].x + v[j].y * v[j].y) + (v[j].z * v[j].z + v[j].w * v[j].w); }
    const float q = sqrtf(wave_sum(s) * (1.f / D) + RMS_EPS), r = 1.f / q;
    if (rinv && lane == 0) *rinv = q;
    GAS unsigned long long* o8 = (GAS unsigned long long*)orow + lane;
#pragma unroll
    for (int j = 0; j < 4; ++j) o8[64 * j] = (unsigned long long)pk2(v[j].x * r, v[j].y * r) | ((unsigned long long)pk2(v[j].z * r, v[j].w * r) << 32);
}
__device__ __forceinline__ void p0_prologue(Frame& F, const Args& args) {
    const int gw = F.vcu * NWAVES + F.wave, NGW = F.G * NWAVES;
    int base = 0;
    for (int s = 0; s < NSEG; ++s) {
        const SegC sg = SEGS[s];
        const int nblk = (sg.ncols + 255) / 256, nit = (sg.K / 64) * nblk;
        const float* W = args.in[sg.win]; const float* gk = sg.gin >= 0 ? args.in[sg.gin] : nullptr; bf16* WT = (bf16*)(args.ws + sg.wsoff);
        const int first = (gw - base % NGW + NGW) % NGW;
        for (int it = first; it < nit; it += NGW) {
            const int kb = it / nblk, nb = it % nblk;
            tr_item(W, sg.ldw, 64 * kb, sg.src0 + 256 * nb, sg.ncols - 256 * nb, WT, sg.K, sg.dst0 + (sg.il ? 512 * nb : 256 * nb), sg.il, gk, sg.cs, F.lane, sg.blk);
        }
        base += nit;
    }
    { bf16* MN = (bf16*)(args.ws + WS_MN); for (int m = gw; m < NB * ML; m += NGW) rms_row_to_bf16(args.in[1] + (size_t)m * D, MN + (size_t)m * D, F.lane);
      bf16* WQ = (bf16*)(args.ws + WS_WQRM); const float* Wq = args.in[18]; const float* gq = args.in[16];
      for (int e4 = gw * 64 + F.lane; e4 < D * D / 4; e4 += NGW * 64) { const int c = e4 >> 8; const float sc = gq[c] * (0.0625f * LOG2E); const f32x4 v = ((const GAS f32x4*)Wq)[e4];
          ((GAS unsigned long long*)WQ)[e4] = (unsigned long long)pk2(v.x * sc, v.y * sc) | ((unsigned long long)pk2(v.z * sc, v.w * sc) << 32); } }
    bf16* XN = (bf16*)(args.ws + WS_XN);
    { float* RINV0 = (float*)(args.ws + WS_RINV);
      const bool aff = (F.G == 256); const int mstep = aff ? 256 : NGW, mend = aff ? ((F.vcu >> 5) + 1) * SEQ : T;
      for (int m = aff ? (F.vcu >> 5) * SEQ + (F.vcu & 31) * NWAVES + F.wave : gw; m < mend; m += mstep) rms_row_to_bf16(F.x + (size_t)m * D, XN + (size_t)m * D, F.lane, RINV0 + m); }
}
__device__ __forceinline__ f32x4 bf4_to_f32(unsigned long long w) { f32x4 r; r.x = __builtin_bit_cast(float, (unsigned)(w & 0xffffu) << 16); r.y = __builtin_bit_cast(float, (unsigned)((w >> 16) & 0xffffu) << 16);
    r.z = __builtin_bit_cast(float, (unsigned)((w >> 32) & 0xffffu) << 16); r.w = __builtin_bit_cast(float, (unsigned)(w >> 48) << 16); return r; }
__device__ __forceinline__ void rowwise_res(Frame& F, const bf16* Yb, const float* g, float alpha, const float* xin, bf16* XN, float* RINV, float* outf, const float* gfin) {
    const int gw = F.vcu * NWAVES + F.wave, NGW = F.G * NWAVES, lane = F.lane;
    f32x4 gv[4], gf[4];
#pragma unroll
    for (int j = 0; j < 4; ++j) { gv[j] = ((const GAS f32x4*)g)[lane + 64 * j]; gf[j] = gfin ? ((const GAS f32x4*)gfin)[lane + 64 * j] : (f32x4){1.f, 1.f, 1.f, 1.f}; }
    const bool aff = (F.G == 256); const int mstep = aff ? 256 : NGW, mend = aff ? ((F.vcu >> 5) + 1) * SEQ : T;
    for (int m = aff ? (F.vcu >> 5) * SEQ + (F.vcu & 31) * NWAVES + F.wave : gw; m < mend; m += mstep) {
        const GAS unsigned long long* yr = (const GAS unsigned long long*)(Yb + (size_t)m * D) + lane;
        f32x4 v[4], xv[4]; float s = 0.f;
#pragma unroll
        for (int j = 0; j < 4; ++j) v[j] = bf4_to_f32(yr[64 * j]);
        if (xin) { const GAS f32x4* xr = (const GAS f32x4*)(xin + (size_t)m * D) + lane;
#pragma unroll
            for (int j = 0; j < 4; ++j) xv[j] = xr[64 * j]; }
        else { const GAS unsigned long long* xr = (const GAS unsigned long long*)(XN + (size_t)m * D) + lane; const float ri = RINV[m];
#pragma unroll
            for (int j = 0; j < 4; ++j) xv[j] = bf4_to_f32(xr[64 * j]) * ri; }
#pragma unroll
        for (int j = 0; j < 4; ++j) s += (v[j].x * v[j].x + v[j].y * v[j].y) + (v[j].z * v[j].z + v[j].w * v[j].w);
        const float r = alpha / sqrtf(wave_sum(s) * (1.f / D) + RMS_EPS);
        float s2 = 0.f;
#pragma unroll
        for (int j = 0; j < 4; ++j) { xv[j] = xv[j] + v[j] * gv[j] * r; s2 += (xv[j].x * xv[j].x + xv[j].y * xv[j].y) + (xv[j].z * xv[j].z + xv[j].w * xv[j].w); }
        const float q2 = sqrtf(wave_sum(s2) * (1.f / D) + RMS_EPS), r2 = 1.f / q2;
        if (gfin) { GAS f32x4* xw = (GAS f32x4*)(outf + (size_t)m * D) + lane;
#pragma unroll
            for (int j = 0; j < 4; ++j) xw[64 * j] = xv[j] * gf[j] * r2;
        } else {
            GAS unsigned long long* o8 = (GAS unsigned long long*)(XN + (size_t)m * D) + lane;
#pragma unroll
            for (int j = 0; j < 4; ++j) o8[64 * j] = (unsigned long long)pk2(xv[j].x * r2, xv[j].y * r2) | ((unsigned long long)pk2(xv[j].z * r2, xv[j].w * r2) << 32);
            if (lane == 0) RINV[m] = q2;
        }
    }
}

typedef float f32x16 __attribute__((ext_vector_type(16)));
__device__ __forceinline__ int crow(int r, int hi) { return (r & 3) + 8 * (r >> 2) + 4 * hi; }
__device__ __forceinline__ float logsigmoidf(float x) { return fminf(x, 0.f) - log1pf(expf(-fabsf(x))); }
__device__ __forceinline__ float logsig_fast(float x) { const float t = __builtin_amdgcn_exp2f(-fabsf(x) * LOG2E); return fminf(x, 0.f) - 0.6931471805599453f * __builtin_amdgcn_logf(1.0f + t); }
__device__ __forceinline__ void p0_wsmall(Frame& F, const Args& args) {
    const float* W = args.in[8]; const float* g = args.in[7]; bf16* WSM = (bf16*)(args.ws + WS_WSM);
    const int gt = (F.vcu * NWAVES + F.wave) * 64 + F.lane, NT_ = F.G * NWAVES * 64;
    for (int e = gt; e < 32 * D; e += NT_) { const int c = e >> 10, k = e & 1023; float v = 0.f;
        if (c < 8) v = W[(size_t)k * INW + 1536 + c] * g[k]; else if (c < 24) v = W[(size_t)k * INW + 2568 + (c - 8)] * g[k];
        WSM[e] = (bf16)f2bf(v); }
}
__device__ __forceinline__ void skinny_panel(Frame& F, const Args& args, int panel) {
    const bf16* XN = (const bf16*)(args.ws + WS_XN); const bf16* WSM = (const bf16*)(args.ws + WS_WSM);
    float* ZSM = (float*)(args.ws + WS_ZSM); float* CLOC = (float*)(args.ws + WS_CLOC); float* TOT = (float*)(args.ws + WS_TOT);
    const int lane = F.lane, r32 = lane & 31, hi = lane >> 5, wid = F.wave;
    const int row = panel * 256 + wid * 32 + r32;
    const bf16x8* ap = (const bf16x8*)(XN + (size_t)row * D + 64 * hi);
    const bf16x8* bp = (const bf16x8*)(WSM + (size_t)r32 * D + 64 * hi);
    f32x16 acc = {};
    for (int kb = 0; kb < 8; ++kb) {
        bf16x8 a[8], b[8];
#pragma unroll
        for (int s = 0; s < 8; ++s) { a[s] = ap[kb * 16 + s]; b[s] = bp[kb * 16 + s]; }
#pragma unroll
        for (int s = 0; s < 8; ++s) acc = __builtin_amdgcn_mfma_f32_32x32x16_bf16(a[s], b[s], acc, 0, 0, 0);
    }
    LAS float* lf = (LAS float*)(F.lds + RING_OFF);
    const float bf_ = (r32 < 8) ? args.in[9][r32] : 0.f;
#pragma unroll
    for (int r = 0; r < 16; ++r) { const int rr = wid * 32 + crow(r, hi);
        ZSM[(size_t)(panel * 256 + rr) * 32 + r32] = acc[r];
        if (r32 < 8) lf[rr * 8 + r32] = logsigmoidf(acc[r] + bf_); }
    __syncthreads();
    { const int h = wid; float v[4]; float s = 0.f;
#pragma unroll
      for (int i = 0; i < 4; ++i) { s += lf[(4 * lane + i) * 8 + h]; v[i] = s; }
      float incl = s;
#pragma unroll
      for (int o = 1; o < 64; o <<= 1) { const float t = __shfl_up(incl, o); if (lane >= o) incl += t; }
      const float excl = incl - s;
#pragma unroll
      for (int i = 0; i < 4; ++i) CLOC[(size_t)(panel * 256 + 4 * lane + i) * 8 + h] = excl + v[i];
      if (lane == 63) TOT[panel * 8 + h] = incl; }
    __syncthreads();
}

namespace fox {
typedef __attribute__((ext_vector_type(4))) short s16x4;
typedef float f32x2_t __attribute__((ext_vector_type(2))); typedef __bf16 bf16x2_t __attribute__((ext_vector_type(2)));
typedef short v4i16_t __attribute__((ext_vector_type(4)));
typedef LAS const char* lds_cptr;
constexpr int DM = ZW, SLOTB = 8192, NSLOT = 3;
constexpr int L_K = 0, L_V = NSLOT * SLOTB, L_DK = 2 * NSLOT * SLOTB, L_WS = L_DK + 16384, L_OST = L_WS + NWAVES * 256, L_END = L_OST + NWAVES * 4096;
static_assert(L_END <= RING_BYTES, "fox LDS");
__device__ __forceinline__ unsigned cvtpk_s(float lo, float hi) { f32x2_t v = {lo, hi}; bf16x2_t b = __builtin_convertvector(v, bf16x2_t); return __builtin_bit_cast(unsigned, b); }
__device__ __forceinline__ void glds16(const void* gsrc, unsigned lds_dst) { unsigned keep;
    asm volatile("s_mov_b32 %0, m0\n\ts_mov_b32 m0, %2\n\ts_nop 0\n\tglobal_load_lds_dwordx4 %1, off\n\ts_mov_b32 m0, %0" : "=&s"(keep) : "v"(gsrc), "s"(lds_dst) : "memory"); }
__device__ __forceinline__ void glds16s(const void* sbase, unsigned voff, unsigned lds_dst) { unsigned keep;
    asm volatile("s_mov_b32 %0, m0\n\ts_mov_b32 m0, %3\n\ts_nop 0\n\tglobal_load_lds_dwordx4 %1, %2\n\ts_mov_b32 m0, %0" : "=&s"(keep) : "v"(voff), "s"(sbase), "s"(lds_dst) : "memory"); }
#define FOX_WAIT_BAR(N) asm volatile("s_waitcnt vmcnt(" #N ") lgkmcnt(0)\n\ts_barrier" ::: "memory")
#define FOX_SBAR() __builtin_amdgcn_sched_barrier(0)
__device__ __forceinline__ void kload8(bf16x8* kf, lds_cptr kp) {
    kf[0] = *(LAS const bf16x8*)(kp);        kf[1] = *(LAS const bf16x8*)(kp + 512);
    kf[2] = *(LAS const bf16x8*)(kp + 2048); kf[3] = *(LAS const bf16x8*)(kp + 2560);
    kf[4] = *(LAS const bf16x8*)(kp + 4096); kf[5] = *(LAS const bf16x8*)(kp + 4608);
    kf[6] = *(LAS const bf16x8*)(kp + 6144); kf[7] = *(LAS const bf16x8*)(kp + 6656);
}
__device__ __forceinline__ void kload2(bf16x8* kf, lds_cptr kp, int j) { kf[2 * j] = *(LAS const bf16x8*)(kp + j * 2048); kf[2 * j + 1] = *(LAS const bf16x8*)(kp + j * 2048 + 512); }
__device__ __forceinline__ s16x4 vtr(lds_cptr p) { return __builtin_bit_cast(s16x4, __builtin_amdgcn_ds_read_tr16_b64_v4i16((LAS v4i16_t*)p)); }
__device__ __forceinline__ void cmask(f32x16& p0, f32x16& p1, int jb, int qrel, int hi) {
    const int kb = 64 * jb + 4 * hi;
#pragma unroll
    for (int r = 0; r < 16; ++r) { const int kv = kb + (r & 3) + 8 * (r >> 2); if (kv > qrel) p0[r] = -INFINITY; if (kv + 32 > qrel) p1[r] = -INFINITY; }
}
__device__ __forceinline__ void prefill(f32x16& c0, f32x16& c1, LAS const float* dkl, int t, int hi, float dq) {
    LAS const f32x4* dk4 = (LAS const f32x4*)dkl + 16 * t + hi;
#pragma unroll
    for (int g = 0; g < 4; ++g) { const f32x4 a = dk4[2 * g], bq = dk4[8 + 2 * g];
#pragma unroll
        for (int i = 0; i < 4; ++i) { c0[4 * g + i] = a[i] - dq; c1[4 * g + i] = bq[i] - dq; } }
}
__device__ __forceinline__ void pv(f32x16* o, int vb, bf16x8 pa0, bf16x8 pa1, bf16x8 pa2, bf16x8 pa3) {
#pragma unroll
    for (int d0 = 0; d0 < 2; ++d0) { s16x4 lo[4], hi[4];
#pragma unroll
        for (int ks = 0; ks < 4; ++ks) {
            asm volatile("ds_read_b64_tr_b16 %0,%1 offset:%c2" : "=&v"(lo[ks]) : "v"(vb), "i"(d0 * 4096 + ks * 1024) : "memory");
            asm volatile("ds_read_b64_tr_b16 %0,%1 offset:%c2" : "=&v"(hi[ks]) : "v"(vb), "i"(d0 * 4096 + ks * 1024 + 512) : "memory"); }
        asm volatile("s_waitcnt lgkmcnt(0)" ::: "memory"); FOX_SBAR();
#define FOX_PK(k) (bf16x8){lo[k][0], lo[k][1], lo[k][2], lo[k][3], hi[k][0], hi[k][1], hi[k][2], hi[k][3]}
        o[d0] = __builtin_amdgcn_mfma_f32_32x32x16_bf16(pa0, FOX_PK(0), o[d0], 0, 0, 0);
        o[d0] = __builtin_amdgcn_mfma_f32_32x32x16_bf16(pa1, FOX_PK(1), o[d0], 0, 0, 0);
        o[d0] = __builtin_amdgcn_mfma_f32_32x32x16_bf16(pa2, FOX_PK(2), o[d0], 0, 0, 0);
        o[d0] = __builtin_amdgcn_mfma_f32_32x32x16_bf16(pa3, FOX_PK(3), o[d0], 0, 0, 0);
#undef FOX_PK
    }
}
__device__ __forceinline__ void fox_unit(Frame& F, const Args& args, int b, int h, int qb, bool stage_dk) {
    const int tid = F.tid, lane = F.lane, r32 = lane & 31, hi = lane >> 5, wid = F.wave;
    const bf16* Zb = (const bf16*)(args.ws + WS_BIG) + (size_t)b * SEQ * DM;
    const float* CLOC = (const float*)(args.ws + WS_CLOC); const float* TOT = (const float*)(args.ws + WS_TOT);
    bf16* OMIX = (bf16*)(args.ws + WS_XNB);
    const unsigned lds0 = (unsigned)(uintptr_t)F.lds;
    LAS float* dkl = (LAS float*)(F.lds + L_DK);
    const int q0 = qb * 256, NTF = (q0 + 256) / 64;
    if (stage_dk) for (int s = tid; s < q0 + 256; s += NWAVES * 64) { const int p = s >> 8; float off = 0.f;
        for (int pp = 0; pp < p; ++pp) off += TOT[(b * 16 + pp) * 8 + h];
        dkl[s] = -(off + CLOC[((size_t)b * SEQ + s) * 8 + h]) * LOG2E; }
    bf16x8 qr[4];
    { const bf16* Qw = Zb + (size_t)(q0 + wid * 32 + r32) * DM + h * 64;
#pragma unroll
      for (int d0 = 0; d0 < 4; ++d0) qr[d0] = *(const bf16x8*)(Qw + d0 * 16 + hi * 8); }
    FOX_WAIT_BAR(0);
    int t0;
    { const int cand = 2 * lane + 2;
      const bool ok = (cand <= NTF - 4) && (dkl[q0] - dkl[64 * cand - 1] > 128.0f);
      t0 = 2 * __builtin_popcountll(__ballot(ok)); }
    const int NT = NTF - t0;
    const float dq = dkl[q0 + wid * 32 + r32];
    LAS const float* dkt = (LAS const float*)(F.lds + L_DK) + 64 * t0;
    const bf16* kbase = Zb + 512 + h * 64 + (size_t)(64 * t0) * DM;
    const bf16* vbase = Zb + 1024 + h * 64 + (size_t)(64 * t0) * DM;
    const unsigned koff = (unsigned)(lane * DM + wid * 8) * 2u;
    const unsigned voff = (unsigned)((16 * (wid & 3) + (lane >> 2)) * DM + (wid >> 2) * 32 + (lane & 3) * 8) * 2u;
    const unsigned kdst = lds0 + L_K + wid * 1024, vdst = lds0 + L_V + wid * 1024;
#define DMA_K(t, slot) glds16s(kbase + (size_t)(t) * 64 * DM, koff, (unsigned)__builtin_amdgcn_readfirstlane(kdst + (slot)))
#define DMA_V(t, slot) glds16s(vbase + (size_t)(t) * 64 * DM, voff, (unsigned)__builtin_amdgcn_readfirstlane(vdst + (slot)))
    const int vb0 = (int)(lds0 + L_V) + ((lane >> 4) & 1) * 32 + (lane & 3) * 8 + (4 * hi + ((lane & 15) >> 2)) * 64;
    const lds_cptr kp0 = (lds_cptr)(F.lds + L_K + hi * 1024 + r32 * 16);
    const lds_cptr vp0 = (lds_cptr)(F.lds + L_V + ((lane >> 4) & 1) * 32 + (lane & 3) * 8 + (4 * hi + ((lane & 15) >> 2)) * 64);
    DMA_K(0, 0); DMA_V(0, 0); DMA_K(1, SLOTB); DMA_K(2, 2 * SLOTB);
    const int qrel = wid * 32 + r32;
    float l_reg = 0.f; f32x16 o[2]; o[0] = f32x16{}; o[1] = f32x16{};
    bf16x8 kf[8];
#define CMASK(P0, P1, t) do { const int jb_ = (t) - (NT - 4); if (jb_ >= 0) cmask(P0, P1, jb_, qrel, hi); } while (0)
    f32x16 pA0, pA1, pB0, pB1;
    int sl_prev = 0, sl_cur = 0, sl_next = SLOTB;
#define ROT() do { sl_prev = sl_cur; sl_cur = sl_next; sl_next = (sl_next == (NSLOT - 1) * SLOTB) ? 0 : sl_next + SLOTB; } while (0)
    FOX_WAIT_BAR(3);
    kload8(kf, kp0); prefill(pA0, pA1, dkt, 0, hi, dq);
    pA0 = __builtin_amdgcn_mfma_f32_32x32x16_bf16(kf[0], qr[0], pA0, 0, 0, 0); pA1 = __builtin_amdgcn_mfma_f32_32x32x16_bf16(kf[1], qr[0], pA1, 0, 0, 0);
    pA0 = __builtin_amdgcn_mfma_f32_32x32x16_bf16(kf[2], qr[1], pA0, 0, 0, 0); pA1 = __builtin_amdgcn_mfma_f32_32x32x16_bf16(kf[3], qr[1], pA1, 0, 0, 0);
    pA0 = __builtin_amdgcn_mfma_f32_32x32x16_bf16(kf[4], qr[2], pA0, 0, 0, 0); pA1 = __builtin_amdgcn_mfma_f32_32x32x16_bf16(kf[5], qr[2], pA1, 0, 0, 0);
    pA0 = __builtin_amdgcn_mfma_f32_32x32x16_bf16(kf[6], qr[3], pA0, 0, 0, 0); pA1 = __builtin_amdgcn_mfma_f32_32x32x16_bf16(kf[7], qr[3], pA1, 0, 0, 0);
    CMASK(pA0, pA1, 0);
#pragma unroll
    for (int r = 0; r < 16; ++r) { pA0[r] = __builtin_amdgcn_exp2f(pA0[r]); pA1[r] = __builtin_amdgcn_exp2f(pA1[r]); }
    FOX_WAIT_BAR(0);
    DMA_K(3, 0); DMA_V(1, SLOTB);
    ROT();
    kload8(kf, kp0 + sl_cur);
    FOX_WAIT_BAR(2);
    s16x4 vlo[8], vhi[8]; v4u pw0, pw1, pw2, pw3;
#define PKW(P, B) cvtpk_s(P[B], P[B + 1])
#define PAF(k) __builtin_bit_cast(bf16x8, pw##k)
#define VFR(i) (bf16x8){vlo[i][0], vlo[i][1], vlo[i][2], vlo[i][3], vhi[i][0], vhi[i][1], vhi[i][2], vhi[i][3]}
#define PIN(x) asm volatile("" : "+v"(x))
#define MF(a, b, c) __builtin_amdgcn_mfma_f32_32x32x16_bf16(a, b, c, 0, 0, 0)
#define GAPA(MFS, A0, A1, A2, A3, W0, W1, PW) do { MFS; sacc += A0; sacc += A1; sacc += A2; sacc += A3; PIN(sacc); W0; W1; PIN(PW); FOX_SBAR(); } while (0)
#define EX(v) __builtin_amdgcn_exp2f(v)
#define GAPB(MFS, X, B) do { MFS; X[B] = EX(X[B]); X[B + 1] = EX(X[B + 1]); X[B + 2] = EX(X[B + 2]); X[B + 3] = EX(X[B + 3]); PIN(X); FOX_SBAR(); } while (0)
#define VRD(i) do { vlo[i] = vtr(vp_ + (((i) >> 2) * 4096 + ((i) & 3) * 1024)); vhi[i] = vtr(vp_ + (((i) >> 2) * 4096 + ((i) & 3) * 1024 + 512)); } while (0)
#define KRD(G, j) do { if (G) { kload2(kf, kp0 + sl_next, j); FOX_SBAR(); } } while (0)
#define STEP(C0, C1, P0, P1, t, GK, GV, GL) do { FOX_SBAR(); \
    const lds_cptr vp_ = vp0 + sl_prev; prefill(C0, C1, dkt, (t), hi, dq); PIN(C0); PIN(C1); FOX_SBAR(); \
    VRD(0); FOX_SBAR(); float sacc = (P0[0] + P0[1]); \
    GAPA(C0 = MF(kf[0], qr[0], C0),  P0[2], P0[3], P0[4], P0[5],     pw0[0] = PKW(P0, 0), pw0[1] = PKW(P0, 2), pw0); \
    VRD(4); FOX_SBAR(); GAPA(C1 = MF(kf[1], qr[0], C1),  P0[6], P0[7], P0[8], P0[9],     pw0[2] = PKW(P0, 4), pw0[3] = PKW(P0, 6), pw0); \
    VRD(1); FOX_SBAR(); GAPA(C0 = MF(kf[2], qr[1], C0),  P0[10], P0[11], P0[12], P0[13], pw1[0] = PKW(P0, 8), pw1[1] = PKW(P0, 10), pw1); \
    VRD(5); FOX_SBAR(); GAPA(C1 = MF(kf[3], qr[1], C1),  P0[14], P0[15], P1[0], P1[1],   pw1[2] = PKW(P0, 12), pw1[3] = PKW(P0, 14), pw1); \
    VRD(2); FOX_SBAR(); GAPA(C0 = MF(kf[4], qr[2], C0),  P1[2], P1[3], P1[4], P1[5],     pw2[0] = PKW(P1, 0), pw2[1] = PKW(P1, 2), pw2); \
    VRD(6); FOX_SBAR(); GAPA(C1 = MF(kf[5], qr[2], C1),  P1[6], P1[7], P1[8], P1[9],     pw2[2] = PKW(P1, 4), pw2[3] = PKW(P1, 6), pw2); \
    VRD(3); FOX_SBAR(); GAPA(C0 = MF(kf[6], qr[3], C0),  P1[10], P1[11], P1[12], P1[13], pw3[0] = PKW(P1, 8), pw3[1] = PKW(P1, 10), pw3); \
    VRD(7); FOX_SBAR(); GAPA(C1 = MF(kf[7], qr[3], C1),  P1[14], P1[15], 0.f, 0.f,       pw3[2] = PKW(P1, 12), pw3[3] = PKW(P1, 14), pw3); \
    l_reg += sacc; \
    if (GK) { DMA_K((t) + 3, sl_cur); } if (GV) { DMA_V((t) + 1, sl_next); } \
    CMASK(C0, C1, t); \
    FOX_SBAR(); \
    GAPB(o[0] = MF(PAF(0), VFR(0), o[0]), C0, 0); \
    GAPB(o[1] = MF(PAF(0), VFR(4), o[1]), C0, 4); \
    KRD(GL, 0); GAPB(o[0] = MF(PAF(1), VFR(1), o[0]), C0, 8); \
    KRD(GL, 1); GAPB(o[1] = MF(PAF(1), VFR(5), o[1]), C0, 12); \
    KRD(GL, 2); GAPB(o[0] = MF(PAF(2), VFR(2), o[0]), C1, 0); \
    KRD(GL, 3); GAPB(o[1] = MF(PAF(2), VFR(6), o[1]), C1, 4); \
    GAPB(o[0] = MF(PAF(3), VFR(3), o[0]), C1, 8); \
    GAPB(o[1] = MF(PAF(3), VFR(7), o[1]), C1, 12); \
    } while (0)
    int t = 1;
#undef CMASK
#define CMASK(P0, P1, t) do { } while (0)
    for (; t + 5 < NT; t += 2) {
        STEP(pB0, pB1, pA0, pA1, t, true, true, true);     FOX_WAIT_BAR(2); ROT();
        STEP(pA0, pA1, pB0, pB1, t + 1, true, true, true); FOX_WAIT_BAR(2); ROT();
    }
#undef CMASK
#define CMASK(P0, P1, t) do { const int jb_ = (t) - (NT - 4); if (jb_ >= 0) cmask(P0, P1, jb_, qrel, hi); } while (0)
#define ENDW(tt) do { if ((tt) + 3 < NT) { FOX_WAIT_BAR(2); } else if ((tt) + 2 < NT) { FOX_WAIT_BAR(1); } else { FOX_WAIT_BAR(0); } } while (0)
    for (; t + 1 < NT; t += 2) {
        STEP(pB0, pB1, pA0, pA1, t, (t + 3 < NT), (t + 1 < NT), (t + 1 < NT));         ENDW(t);     ROT();
        STEP(pA0, pA1, pB0, pB1, t + 1, (t + 4 < NT), (t + 2 < NT), (t + 2 < NT));     ENDW(t + 1); ROT();
    }
    STEP(pB0, pB1, pA0, pA1, NT - 1, false, false, false);
    { float sacc = pB0[0] + pB0[1];
#pragma unroll
      for (int r = 2; r < 16; ++r) sacc += pB0[r];
#pragma unroll
      for (int r = 0; r < 16; ++r) sacc += pB1[r];
      l_reg += sacc;
      pw0 = (v4u){PKW(pB0, 0), PKW(pB0, 2), PKW(pB0, 4), PKW(pB0, 6)}; pw1 = (v4u){PKW(pB0, 8), PKW(pB0, 10), PKW(pB0, 12), PKW(pB0, 14)};
      pw2 = (v4u){PKW(pB1, 0), PKW(pB1, 2), PKW(pB1, 4), PKW(pB1, 6)}; pw3 = (v4u){PKW(pB1, 8), PKW(pB1, 10), PKW(pB1, 12), PKW(pB1, 14)};
      FOX_SBAR(); pv(o, vb0 + sl_cur, PAF(0), PAF(1), PAF(2), PAF(3)); }
    l_reg += __shfl_xor(l_reg, 32);
    LAS float* wsf = (LAS float*)(F.lds + L_WS) + wid * 64;
    if (hi == 0) wsf[r32] = l_reg;
    LDS_WAIT();
    { float ss[16];
#pragma unroll
      for (int r = 0; r < 16; ++r) { const float rl = __builtin_amdgcn_rcpf(wsf[crow(r, hi)]); o[0][r] *= rl; o[1][r] *= rl; ss[r] = o[0][r] * o[0][r] + o[1][r] * o[1][r]; }
#pragma unroll
      for (int off = 1; off < 32; off <<= 1)
#pragma unroll
          for (int r = 0; r < 16; ++r) ss[r] += __shfl_xor(ss[r], off);
      const float g0 = args.in[12][h * 64 + r32], g1 = args.in[12][h * 64 + 32 + r32];
      LAS unsigned short* stg = (LAS unsigned short*)(F.lds + L_OST) + wid * 2048;
#pragma unroll
      for (int r = 0; r < 16; ++r) { const int orow = crow(r, hi); const float rs = 1.0f / sqrtf(ss[r] * (1.0f / 64.0f) + RMS_EPS);
          stg[orow * 64 + r32] = (unsigned short)f2bf(o[0][r] * rs * g0); stg[orow * 64 + 32 + r32] = (unsigned short)f2bf(o[1][r] * rs * g1); }
      LDS_WAIT();
#pragma unroll
      for (int i = 0; i < 4; ++i) { const int row = i * 8 + (lane >> 3), ch = lane & 7; const v4u v = *(LAS const v4u*)(stg + row * 64 + ch * 8);
          *(v4u*)(OMIX + ((size_t)b * SEQ + q0 + wid * 32 + row) * D + h * 64 + ch * 8) = v; } }
    FOX_WAIT_BAR(0);
#undef DMA_K
#undef DMA_V
#undef CMASK
#undef ROT
#undef PKW
#undef PAF
#undef VFR
#undef PIN
#undef MF
#undef GAPA
#undef GAPB
#undef EX
#undef VRD
#undef KRD
#undef STEP
#undef ENDW
}
__device__ __forceinline__ void fox_phase(Frame& F, const Args& args) {
    if (F.G == 256) {
        const int bh = F.vcu >> 2, s = F.vcu & 3, b = bh >> 3, h = bh & 7;
        { const float* CLOC = (const float*)(args.ws + WS_CLOC); const float* TOT = (const float*)(args.ws + WS_TOT); LAS float* dkl = (LAS float*)(F.lds + L_DK);
          __syncthreads();
          for (int k = F.tid; k < SEQ; k += NWAVES * 64) { const int p = k >> 8; float off = 0.f;
              for (int pp = 0; pp < p; ++pp) off += TOT[(b * 16 + pp) * 8 + h];
              dkl[k] = -(off + CLOC[((size_t)b * SEQ + k) * 8 + h]) * LOG2E; } }
        for (int i = 0; i < 4; ++i) { const int qb = (i == 0) ? s : (i == 1) ? 7 - s : (i == 2) ? 8 + s : 15 - s; fox_unit(F, args, b, h, qb, false); }
    }
}
}
namespace gla {
constexpr size_t WS_DEC = 456 * MiB;
__device__ __forceinline__ bf16* kvn_ptr(unsigned char* ws, int ck) { return (bf16*)(ws + WS_Y + (size_t)(ck >> 8) * Y_SLICE) + (size_t)(ck & 255) * 8192; }
__device__ __forceinline__ bf16* spt_ptr(unsigned char* ws, int ck) { return (bf16*)(ws + WS_Y + (size_t)(ck >> 8) * Y_SLICE + 4 * MiB) + (size_t)(ck & 255) * 8192; }
constexpr int PITCH = 144;
__device__ __forceinline__ float bf2f(unsigned short v) { return __builtin_bit_cast(float, (unsigned)v << 16); }
__device__ __forceinline__ float ex(float x) { return __builtin_amdgcn_exp2f(x * LOG2E); }
__device__ __forceinline__ void stage_vt(LAS unsigned char* VT, const bf16* Zr, int h, int tid) {
#pragma unroll
    for (int i = 0; i < 2; ++i) { const int p = tid + i * 512, c = p >> 4, ch = p & 15;
        const v4u w = *(const v4u*)(Zr + (size_t)c * ZW + 2048 + h * 128 + 8 * ch);
        LAS unsigned short* dst = (LAS unsigned short*)(VT + (8 * ch) * PITCH + 2 * c);
        dst[0 * (PITCH / 2)] = (unsigned short)(w.x & 0xffff); dst[1 * (PITCH / 2)] = (unsigned short)(w.x >> 16);
        dst[2 * (PITCH / 2)] = (unsigned short)(w.y & 0xffff); dst[3 * (PITCH / 2)] = (unsigned short)(w.y >> 16);
        dst[4 * (PITCH / 2)] = (unsigned short)(w.z & 0xffff); dst[5 * (PITCH / 2)] = (unsigned short)(w.z >> 16);
        dst[6 * (PITCH / 2)] = (unsigned short)(w.w & 0xffff); dst[7 * (PITCH / 2)] = (unsigned short)(w.w >> 16); }
}
__device__ __forceinline__ void gla_a_iter(Frame& F, const Args& args, int u) {
    const int lane = F.lane, r32 = lane & 31, hi = lane >> 5, wid = F.wave, cl = wid >> 1, ct = wid & 1;
    const int ck = 4 * u + cl, bh = ck >> 6, n = ck & 63, b = bh >> 2, h = bh & 3;
    const size_t tok0 = (size_t)b * SEQ + n * 64;
    bf16* Zr = (bf16*)(args.ws + WS_BIG) + tok0 * ZW;
    const float* ZSM = (const float*)(args.ws + WS_ZSM);
    bf16* KVNc = kvn_ptr(args.ws, ck); float* DEC = (float*)(args.ws + WS_DEC);
    LAS unsigned char* base = F.lds + cl * 30720;
    LAS unsigned char* VIMG = base; LAS unsigned char* KDT = base + 16384; LAS float* GG = (LAS float*)(base + 16384 + 9216); LAS float* SEG = (LAS float*)(base + 16384 + 9216 + 4096);
    const int tp = ct * 64 + lane, d = lane;
    { v4u vv[8];
#pragma unroll
      for (int i = 0; i < 8; ++i) { const int p = tp + 128 * i, s = p >> 4, ch = p & 15; vv[i] = *(const v4u*)(Zr + (size_t)s * ZW + 2048 + h * 128 + 8 * ch); }
      f32x4 gq[2];
#pragma unroll
      for (int i = 0; i < 2; ++i) { const int p = tp + 128 * i, c = p >> 2, pc = p & 3; gq[i] = *(const f32x4*)(ZSM + (tok0 + c) * 32 + 8 + 4 * pc); }
#pragma unroll
      for (int i = 0; i < 8; ++i) { const int p = tp + 128 * i, s = p >> 4, ch = p & 15; *(LAS v4u*)(VIMG + (ch >> 2) * 4096 + s * 64 + (ch & 3) * 16) = vv[i]; }
#pragma unroll
      for (int i = 0; i < 2; ++i) { const int p = tp + 128 * i, c = p >> 2, pc = p & 3; *(LAS f32x4*)(GG + c * 16 + 4 * pc) = gq[i]; } }
    float w[16];
#pragma unroll
    for (int r = 0; r < 16; ++r) w[r] = args.in[10][r * 256 + h * 64 + d];
    const float bgd = args.in[11][h * 64 + d];
    LDS_WAIT(); __syncthreads();
    float bc[32]; float run = 0.f;
#pragma unroll
    for (int i = 0; i < 32; ++i) { const int c = 32 * ct + i; float a = bgd;
#pragma unroll
        for (int q4 = 0; q4 < 4; ++q4) { const f32x4 g4 = *(LAS const f32x4*)(GG + c * 16 + 4 * q4);
            a = fmaf(g4.x, w[4 * q4], a); a = fmaf(g4.y, w[4 * q4 + 1], a); a = fmaf(g4.z, w[4 * q4 + 2], a); a = fmaf(g4.w, w[4 * q4 + 3], a); }
        run += logsig_fast(a) * (1.0f / 16.0f); bc[i] = run; }
    SEG[ct * 64 + d] = run;
    LDS_WAIT(); __syncthreads();
    const float s0 = SEG[d], s1 = SEG[64 + d], tot = s0 + s1, pre = ct ? s0 : 0.f;
#pragma unroll
    for (int i8 = 0; i8 < 4; ++i8) { unsigned kd[8];
#pragma unroll
        for (int j = 0; j < 8; ++j) { const int i = 8 * i8 + j, c = 32 * ct + i; const float bcum = pre + bc[i];
            bf16* qp = Zr + (size_t)c * ZW + 1536 + h * 64 + d; bf16* kp = Zr + (size_t)c * ZW + 1792 + h * 64 + d;
            const float q = bf2f(*qp), k = bf2f(*kp);
            *qp = (bf16)f2bf(q * ex(bcum)); *kp = (bf16)f2bf(k * ex(-bcum)); kd[j] = f2bf(k * ex(tot - bcum)); }
        v4u o; o.x = kd[0] | (kd[1] << 16); o.y = kd[2] | (kd[3] << 16); o.z = kd[4] | (kd[5] << 16); o.w = kd[6] | (kd[7] << 16);
        *(LAS v4u*)(KDT + d * PITCH + (32 * ct + 8 * i8) * 2) = o; }
    if (ct == 0) DEC[(size_t)ck * 64 + d] = ex(tot);
    LDS_WAIT(); __syncthreads();
    { f32x16 acc[4];
      bf16x8 af[4];
#pragma unroll
      for (int ks = 0; ks < 4; ++ks) af[ks] = *(LAS const bf16x8*)(KDT + (32 * ct + r32) * PITCH + (16 * ks + 8 * hi) * 2);
      const fox::lds_cptr vp = (fox::lds_cptr)(VIMG + (8 * hi + ((lane & 15) >> 2)) * 64 + ((lane >> 4) & 1) * 32 + (lane & 3) * 8);
#pragma unroll
      for (int et = 0; et < 4; ++et) { acc[et] = f32x16{};
#pragma unroll
          for (int ks = 0; ks < 4; ++ks) { const fox::s16x4 lo = fox::vtr(vp + et * 4096 + ks * 1024), hh = fox::vtr(vp + et * 4096 + ks * 1024 + 256);
              acc[et] = __builtin_amdgcn_mfma_f32_32x32x16_bf16(af[ks], (bf16x8){lo[0], lo[1], lo[2], lo[3], hh[0], hh[1], hh[2], hh[3]}, acc[et], 0, 0, 0); } }
#pragma unroll
      for (int et = 0; et < 4; ++et) { bf16* dst = KVNc + (size_t)(32 * et + r32) * 64 + 32 * ct + 4 * hi;
#pragma unroll
          for (int g = 0; g < 4; ++g) { v2u o; o.x = pk2(acc[et][4 * g], acc[et][4 * g + 1]); o.y = pk2(acc[et][4 * g + 2], acc[et][4 * g + 3]); *(v2u*)(dst + 8 * g) = o; } } }
    LDS_WAIT(); __syncthreads();
}
__device__ __forceinline__ void gla_b(Frame& F, const Args& args) {
    const float* DEC = (const float*)(args.ws + WS_DEC);
    const bool aff = (F.G == 256);
    const int gid = aff ? (F.vcu >> 5) * 32768 + ((F.vcu & 31) * NWAVES + F.wave) * 64 + F.lane : (F.vcu * NWAVES + F.wave) * 64 + F.lane;
    const int stride = aff ? 16384 : F.G * NWAVES * 64, eend = aff ? ((F.vcu >> 5) + 1) * 32768 : 32 * 8192;
    for (int e = gid; e < eend; e += stride) { const int bh = e >> 13, j = e & 8191, d = j & 63; float S = 0.f;
        for (int n0 = 0; n0 < 64; n0 += 8) { float kv[8], dc[8];
#pragma unroll
            for (int i = 0; i < 8; ++i) { const size_t ck = (size_t)bh * 64 + n0 + i; kv[i] = bf2f(kvn_ptr(args.ws, (int)ck)[j]); dc[i] = DEC[ck * 64 + d]; }
#pragma unroll
            for (int i = 0; i < 8; ++i) { const size_t ck = (size_t)bh * 64 + n0 + i; spt_ptr(args.ws, (int)ck)[j] = (bf16)f2bf(S); S = fmaf(dc[i], S, kv[i]); } } }
}
__device__ __forceinline__ void gla_c_iter(Frame& F, const Args& args, int u) {
    const int lane = F.lane, r32 = lane & 31, hi = lane >> 5, wid = F.wave, cl = wid >> 1, ct = wid & 1;
    const int ck = 4 * u + cl, bh = ck >> 6, n = ck & 63, b = bh >> 2, h = bh & 3;
    const size_t tok0 = (size_t)b * SEQ + n * 64;
    const bf16* Zr = (const bf16*)(args.ws + WS_BIG) + tok0 * ZW;
    const bf16* SPTg = spt_ptr(args.ws, ck);
    bf16* OMIX = (bf16*)(args.ws + WS_XNB);
    LAS unsigned char* VIMG = F.lds + cl * 16384;
    LAS unsigned short* stg = (LAS unsigned short*)(F.lds + 65536 + wid * 8192);
    { const int tp = ct * 64 + lane; v4u vv[8];
#pragma unroll
      for (int i = 0; i < 8; ++i) { const int p = tp + 128 * i, s = p >> 4, ch = p & 15; vv[i] = *(const v4u*)(Zr + (size_t)s * ZW + 2048 + h * 128 + 8 * ch); }
#pragma unroll
      for (int i = 0; i < 8; ++i) { const int p = tp + 128 * i, s = p >> 4, ch = p & 15; *(LAS v4u*)(VIMG + (ch >> 2) * 4096 + s * 64 + (ch & 3) * 16) = vv[i]; } }
    bf16x8 qd[4], ki0[4], ki1[4];
    { const bf16* qp = Zr + (size_t)(32 * ct + r32) * ZW + 1536 + h * 64 + 8 * hi; const bf16* kp = Zr + (size_t)r32 * ZW + 1792 + h * 64 + 8 * hi;
#pragma unroll
      for (int ks = 0; ks < 4; ++ks) { qd[ks] = *(const bf16x8*)(qp + 16 * ks); ki0[ks] = *(const bf16x8*)(kp + 16 * ks); ki1[ks] = ct ? *(const bf16x8*)(kp + (size_t)32 * ZW + 16 * ks) : ki0[ks]; } }
    f32x16 p0 = {}, p1 = {};
#pragma unroll
    for (int ks = 0; ks < 4; ++ks) p0 = __builtin_amdgcn_mfma_f32_32x32x16_bf16(ki0[ks], qd[ks], p0, 0, 0, 0);
    if (ct) {
#pragma unroll
        for (int ks = 0; ks < 4; ++ks) p1 = __builtin_amdgcn_mfma_f32_32x32x16_bf16(ki1[ks], qd[ks], p1, 0, 0, 0);
    }
#pragma unroll
    for (int r = 0; r < 16; ++r) { const bool keep = crow(r, hi) <= r32; if (ct) { if (!keep) p1[r] = 0.f; } else { if (!keep) p0[r] = 0.f; } }
    v4u pw0, pw1, pw2, pw3;
    pw0 = (v4u){fox::cvtpk_s(p0[0], p0[1]), fox::cvtpk_s(p0[2], p0[3]), fox::cvtpk_s(p0[4], p0[5]), fox::cvtpk_s(p0[6], p0[7])};
    pw1 = (v4u){fox::cvtpk_s(p0[8], p0[9]), fox::cvtpk_s(p0[10], p0[11]), fox::cvtpk_s(p0[12], p0[13]), fox::cvtpk_s(p0[14], p0[15])};
    pw2 = (v4u){fox::cvtpk_s(p1[0], p1[1]), fox::cvtpk_s(p1[2], p1[3]), fox::cvtpk_s(p1[4], p1[5]), fox::cvtpk_s(p1[6], p1[7])};
    pw3 = (v4u){fox::cvtpk_s(p1[8], p1[9]), fox::cvtpk_s(p1[10], p1[11]), fox::cvtpk_s(p1[12], p1[13]), fox::cvtpk_s(p1[14], p1[15])};
    f32x16 o[4];
#pragma unroll
    for (int et = 0; et < 4; ++et) { o[et] = f32x16{};
        const bf16* sp = SPTg + (size_t)(32 * et + r32) * 64 + 8 * hi;
        bf16x8 sf[4];
#pragma unroll
        for (int ks = 0; ks < 4; ++ks) sf[ks] = *(const bf16x8*)(sp + 16 * ks);
#pragma unroll
        for (int ks = 0; ks < 4; ++ks) o[et] = __builtin_amdgcn_mfma_f32_32x32x16_bf16(qd[ks], sf[ks], o[et], 0, 0, 0); }
    LDS_WAIT(); asm volatile("s_waitcnt vmcnt(0)" ::: "memory"); __syncthreads();
    { const fox::lds_cptr vp = (fox::lds_cptr)(VIMG + ((lane >> 4) & 1) * 32 + (lane & 3) * 8 + (4 * hi + ((lane & 15) >> 2)) * 64);
#pragma unroll
      for (int et = 0; et < 4; ++et) { fox::s16x4 lo[4], hh[4];
#pragma unroll
          for (int ks = 0; ks < 4; ++ks) { lo[ks] = fox::vtr(vp + et * 4096 + ks * 1024); hh[ks] = fox::vtr(vp + et * 4096 + ks * 1024 + 512); }
#define GLA_PK(k) (bf16x8){lo[k][0], lo[k][1], lo[k][2], lo[k][3], hh[k][0], hh[k][1], hh[k][2], hh[k][3]}
          o[et] = __builtin_amdgcn_mfma_f32_32x32x16_bf16(__builtin_bit_cast(bf16x8, pw0), GLA_PK(0), o[et], 0, 0, 0);
          o[et] = __builtin_amdgcn_mfma_f32_32x32x16_bf16(__builtin_bit_cast(bf16x8, pw1), GLA_PK(1), o[et], 0, 0, 0);
          if (ct) { o[et] = __builtin_amdgcn_mfma_f32_32x32x16_bf16(__builtin_bit_cast(bf16x8, pw2), GLA_PK(2), o[et], 0, 0, 0);
                    o[et] = __builtin_amdgcn_mfma_f32_32x32x16_bf16(__builtin_bit_cast(bf16x8, pw3), GLA_PK(3), o[et], 0, 0, 0); }
#undef GLA_PK
      } }
    { float ss[16];
#pragma unroll
      for (int r = 0; r < 16; ++r) ss[r] = (o[0][r] * o[0][r] + o[1][r] * o[1][r]) + (o[2][r] * o[2][r] + o[3][r] * o[3][r]);
#pragma unroll
      for (int off = 1; off < 32; off <<= 1)
#pragma unroll
          for (int r = 0; r < 16; ++r) ss[r] += __shfl_xor(ss[r], off);
#pragma unroll
      for (int r = 0; r < 16; ++r) { const float rs = 1.0f / sqrtf(ss[r] * (1.0f / 128.0f) + RMS_EPS); const int orow = crow(r, hi);
#pragma unroll
          for (int et = 0; et < 4; ++et) stg[orow * 128 + 32 * et + r32] = (unsigned short)f2bf(o[et][r] * rs); } }
    LDS_WAIT();
    { const int ch = lane & 15; const float* gp = args.in[13] + h * 128 + ch * 8; const f32x4 g0 = *(const f32x4*)gp, g1 = *(const f32x4*)(gp + 4);
#pragma unroll
      for (int i = 0; i < 8; ++i) { const int row = i * 4 + (lane >> 4);
          const v4u ov = *(LAS const v4u*)(stg + row * 128 + ch * 8);
          const v4u gr = *(const v4u*)(Zr + (size_t)(32 * ct + row) * ZW + 2560 + h * 128 + ch * 8);
          float x[8], q[8];
          x[0] = bf2f((unsigned short)(ov.x & 0xffff)); x[1] = bf2f((unsigned short)(ov.x >> 16)); x[2] = bf2f((unsigned short)(ov.y & 0xffff)); x[3] = bf2f((unsigned short)(ov.y >> 16));
          x[4] = bf2f((unsigned short)(ov.z & 0xffff)); x[5] = bf2f((unsigned short)(ov.z >> 16)); x[6] = bf2f((unsigned short)(ov.w & 0xffff)); x[7] = bf2f((unsigned short)(ov.w >> 16));
          q[0] = bf2f((unsigned short)(gr.x & 0xffff)); q[1] = bf2f((unsigned short)(gr.x >> 16)); q[2] = bf2f((unsigned short)(gr.y & 0xffff)); q[3] = bf2f((unsigned short)(gr.y >> 16));
          q[4] = bf2f((unsigned short)(gr.z & 0xffff)); q[5] = bf2f((unsigned short)(gr.z >> 16)); q[6] = bf2f((unsigned short)(gr.w & 0xffff)); q[7] = bf2f((unsigned short)(gr.w >> 16));
          const float gg[8] = {g0.x, g0.y, g0.z, g0.w, g1.x, g1.y, g1.z, g1.w};
          float y[8];
#pragma unroll
          for (int j = 0; j < 8; ++j) y[j] = x[j] * gg[j] * q[j] * __builtin_amdgcn_rcpf(1.0f + __builtin_amdgcn_exp2f(-LOG2E * q[j]));
          v4u w; w.x = pk2(y[0], y[1]); w.y = pk2(y[2], y[3]); w.z = pk2(y[4], y[5]); w.w = pk2(y[6], y[7]);
          *(v4u*)(OMIX + (tok0 + 32 * ct + row) * D + 512 + h * 128 + ch * 8) = w; } }
    LDS_WAIT(); __syncthreads();
}
}


struct KvmOrder {
    int c;
    __device__ __forceinline__ bool next(int i, pg8::Unit& u) const { if (i > 0 || c >= 64) return false; u.pm = c >> 3; u.pn = c & 7; u.aoff = (long)u.pm * 256 * D; u.boff = (long)u.pn * 256 * D; return true; }
    __device__ __forceinline__ void a_ready(const pg8::Unit&) const {}
    __device__ __forceinline__ void done(const pg8::Unit&) const {}
};
#define XL_CNT(j) (3520 + 64 * (j))
#define XL_GEN(j) (4544 + 64 * (j))
__device__ __forceinline__ void xcc_local_barrier(unsigned* bar, unsigned x) {
    asm volatile("s_waitcnt vmcnt(0)" ::: "memory");
    __syncthreads();
    if (threadIdx.x == 0) {
        __builtin_amdgcn_s_waitcnt(0);
        const unsigned old = xb_add(&bar[XL_CNT(x)], 1u), gen = old / 32u;
        if (old + 1u == (gen + 1u) * 32u) xb_add(&bar[XL_GEN(x)], 1u);
        else XB_SPIN(xb_ld(&bar[XL_GEN(x)]) == gen, bar);
        __builtin_amdgcn_fence(__ATOMIC_ACQUIRE, "agent");
        asm volatile("s_waitcnt vmcnt(0)" ::: "memory");
    }
    __syncthreads();
}
struct MemPrepOrder {
    int c;
    __device__ __forceinline__ bool next(int i, pg8::Unit& u) const { if (i > 0 || c >= 256) return false; const int r = c & 31, b = c >> 5, h = (r >> 2) & 3, t4 = r & 3;
        if (r < 16) { u.pm = h; u.pn = t4; u.aoff = (long)(WS_KVM / 2) + (long)(b * 256) * 2048 + h * 256; u.boff = (long)(WS_WQRM / 2) + (long)(t4 * 256) * D + h * 256; }
        else { u.pm = t4; u.pn = h; u.aoff = (long)(WS_WOT / 2) + (long)(t4 * 256) * D + h * 256; u.boff = (long)(WS_KVM / 2) + (long)(b * 256) * 2048 + 1024 + h * 256; }
        return true; }
    __device__ __forceinline__ void a_ready(const pg8::Unit&) const {}
    __device__ __forceinline__ void done(const pg8::Unit&) const {}
};
#ifndef PG8_SP2
#define PG8_SP2 true
#endif
#ifndef PG8_ALIGN
#define PG8_ALIGN true
#endif

__global__ void __launch_bounds__(NWAVES * 64, 2) mk_fwd(Args args) {
    extern __shared__ __attribute__((aligned(16))) unsigned char lds[];
    Frame F;
    F.lds = (LAS unsigned char*)lds;
    F.tid = threadIdx.x; F.lane = F.tid & 63; F.wave = __builtin_amdgcn_readfirstlane(F.tid >> 6);
    F.G = gridDim.x; { const int bx = blockIdx.x; F.vcu = (F.G % 8 == 0) ? (bx % 8) * (F.G / 8) + bx / 8 : bx; }
    F.x = args.in[0]; F.out = args.out; F.ws = args.ws;
    unsigned char* ws = args.ws;
    bf16* XN = (bf16*)(ws + WS_XN); bf16* HB = (bf16*)(ws + WS_BIG); bf16* Y = (bf16*)(ws + WS_Y); bf16* XNB = (bf16*)(ws + WS_XNB); float* RINV = (float*)(ws + WS_RINV);
    const int lo = args.ph_lo, hi = args.ph_hi;
#define IN(k) (lo <= (k) && (k) < hi)
    for (int u = F.tid; u < (LDS_BYTES - LDSCTL_OFF) / 4; u += NWAVES * 64) ((LAS unsigned*)(F.lds + LDSCTL_OFF))[u] = 0u;
    __syncthreads();
    XcdBarrier bar; bar.bar = (unsigned*)(ws + WS_CTL) + CW_BAR; bar.x = 0; bar.st = nullptr;
    volatile LAS unsigned* MISC = (volatile LAS unsigned*)(F.lds + MISC_OFF);
    int cblk = (int)blockIdx.x; bool local_ok = false;
    if (hi - lo > 1) {
        bar.x = xb_xcc_id(); bar.st = MISC + 8;
        if (F.tid == 0) MISC[12] = xb_add(&bar.bar[XB_XCNT(bar.x)], 1u);
    }
#define GRID_SYNC(k) do { if (IN(k) && IN((k) + 1)) { if (local_ok) xcc_local_barrier(bar.bar, bar.x); else xcd_barrier(bar); } } while (0)
    if (IN(0)) { p0_prologue(F, args); p0_wsmall(F, args); }
    GRID_SYNC(0);
    if (hi - lo > 1) {
        if (F.tid == 0) { unsigned below = 0, npop = 0, ok = 1;
            for (unsigned j = 0; j < 16; ++j) { const unsigned c = xb_ld(&bar.bar[XB_XCNT(j)]); if (c) { ++npop; if (c != 32u) ok = 0; if (j < bar.x) ++below; } }
            MISC[13] = below; MISC[14] = (ok && npop == 8u && F.G == 256) ? 1u : 0u; }
        __syncthreads();
        if (MISC[14]) { const int bx_ = (int)MISC[13], rk = (int)MISC[12]; local_ok = true; F.vcu = bx_ * 32 + rk; cblk = rk * 8 + bx_; }
        __syncthreads();
        if (!local_ok) return;
#ifdef STAGGER_NS
        if (local_ok) { const unsigned long long t0 = __builtin_amdgcn_s_memrealtime(), ticks = (unsigned long long)(F.vcu >> 5) * STAGGER_NS / 10;
            while (__builtin_amdgcn_s_memrealtime() - t0 < ticks) __builtin_amdgcn_s_sleep(8); }
#endif
    }
    const int bb = F.vcu >> 5;
    unsigned char* BIGb = ws + WS_BIG + (size_t)bb * BIG_SLICE;
    bf16* HBb = (bf16*)BIGb - (size_t)(16 * bb) * ((size_t)256 * DFF);
    bf16* Pb = (bf16*)BIGb - (size_t)(16 * bb) * ((size_t)256 * D);
    if (IN(1)) {
        pg8::Gemm g{XN, (const bf16*)(ws + WS_WGU1), D, D, D}; pg8::StaticOrder S; S.init(T, NGU, F.G, cblk, D, D);
        pg8::EpiSwiGLU E{HBb, DFF / 64};
        pg8::gemm_phase<pg8::EpiSwiGLU, pg8::StaticOrder, PG8_ALIGN, PG8_SP2>(F.lds + RING_OFF, g, S, E);
    }
    GRID_SYNC(1);
    if (IN(2)) {
        pg8::Gemm g{HBb, (const bf16*)(ws + WS_WD1), 64, 64, DFF, 256 * 64 * 2, 256 * 64 * 2}; pg8::StaticOrder S; S.init(T, D, F.G, cblk, 64, 64); S.apanel = (long)256 * DFF; S.bpanel = (long)256 * DFF;
        pg8::EpiBf16<0> E{Y, D, nullptr, 0, 0, 1.f};
        pg8::gemm_phase<pg8::EpiBf16<0>, pg8::StaticOrder, PG8_ALIGN, PG8_SP2>(F.lds + RING_OFF, g, S, E);
    }
    GRID_SYNC(2);
    if (IN(3)) {
        rowwise_res(F, Y, args.in[6], 0.5f, nullptr, XN, RINV, nullptr, nullptr);
    }
    GRID_SYNC(3);
    if (IN(4)) {
        pg8::Gemm g{XN, (const bf16*)(ws + WS_WIN), D, D, D}; pg8::StaticOrder S; S.init(T, ZW, F.G, cblk, D, D);
        pg8::EpiBf16<0> E{HB, ZW, nullptr, 0, 0, 1.f};
        pg8::gemm_phase<pg8::EpiBf16<0>, pg8::StaticOrder, PG8_ALIGN, PG8_SP2>(F.lds + RING_OFF, g, S, E);
        __syncthreads();
        if (F.G == 256) { if ((F.vcu & 31) < 16) skinny_panel(F, args, (F.vcu >> 5) * 16 + (F.vcu & 31)); } else for (int p = F.vcu; p < T / 256; p += F.G) skinny_panel(F, args, p);
    }
    GRID_SYNC(4);
    if (IN(5)) {
        if (F.G == 256) { for (int k = 0; k < 2; ++k) gla::gla_a_iter(F, args, (F.vcu >> 5) * 64 + (F.vcu & 31) + 32 * k); } else for (int u = F.vcu; u < 512; u += F.G) gla::gla_a_iter(F, args, u); fox::fox_phase(F, args);
        __syncthreads();
        { pg8::Gemm g{(const bf16*)(ws + WS_MN), (const bf16*)(ws + WS_WKVT), D, D, D}; KvmOrder S{(F.vcu & 3) == 0 ? (F.vcu >> 2) : 64};
          pg8::EpiBf16<0> E{(bf16*)(ws + WS_KVM), 2048, nullptr, 0, 0, 1.f};
          pg8::gemm_phase<pg8::EpiBf16<0>, KvmOrder, PG8_ALIGN, PG8_SP2>(F.lds + RING_OFF, g, S, E); } }
    GRID_SYNC(5);
    if (IN(6)) { gla::gla_b(F, args); }
    GRID_SYNC(6);
    if (IN(7)) { if (F.G == 256) { for (int k = 0; k < 2; ++k) gla::gla_c_iter(F, args, (F.vcu >> 5) * 64 + (F.vcu & 31) + 32 * k); } else for (int u = F.vcu; u < 512; u += F.G) gla::gla_c_iter(F, args, u); }
    GRID_SYNC(7);
    if (IN(8)) {
        { pg8::Gemm g{XNB, (const bf16*)(ws + WS_WOUT), D, D, D}; pg8::StaticOrder S; S.init(T, D, F.G, cblk, D, D);
          pg8::EpiBf16<0> E{Y, D, nullptr, 0, 0, 1.f};
          pg8::gemm_phase<pg8::EpiBf16<0>, pg8::StaticOrder, PG8_ALIGN, PG8_SP2>(F.lds + RING_OFF, g, S, E); }
    }
    GRID_SYNC(8);
    if (IN(9)) {
        rowwise_res(F, Y, args.in[15], 1.0f, nullptr, XN, RINV, nullptr, nullptr);
        __syncthreads();
        { const bool t0 = (F.vcu & 31) < 16;
          pg8::Gemm g{(const bf16*)ws, (const bf16*)ws, t0 ? 2048 : D, t0 ? D : 2048, 256}; MemPrepOrder S{F.vcu};
          pg8::EpiBf16<0> E{(bf16*)(BIGb + (t0 ? SL_WQK : SL_VWOT)), D, nullptr, 0, 0, 1.f};
          pg8::gemm_phase<pg8::EpiBf16<0>, MemPrepOrder, PG8_ALIGN, PG8_SP2>(F.lds + RING_OFF, g, S, E); }
    }
    GRID_SYNC(9);
    if (IN(10)) {
        pg8::Gemm g{XN, (const bf16*)(BIGb + SL_WQK), D, D, D}; pg8::StaticOrder S; S.init(T, D, F.G, cblk, D, D);
        pg8::EpiSoftmax E{Pb, D, (LAS float*)(F.lds + TAB_OFF)};
        pg8::gemm_phase<pg8::EpiSoftmax, pg8::StaticOrder, true, PG8_SP2>(F.lds + RING_OFF, g, S, E);
    }
    GRID_SYNC(10);
    if (IN(11)) {
        pg8::Gemm g{Pb, (const bf16*)(BIGb + SL_VWOT), D, D, D}; pg8::StaticOrder S; S.init(T, D, F.G, cblk, D, D);
        pg8::EpiBf16<0> E{Y, D, nullptr, 0, 0, 1.f};
        pg8::gemm_phase<pg8::EpiBf16<0>, pg8::StaticOrder, PG8_ALIGN, PG8_SP2>(F.lds + RING_OFF, g, S, E);
    }
    GRID_SYNC(11);
    if (IN(12)) {
        rowwise_res(F, Y, args.in[21], 1.0f, nullptr, XN, RINV, nullptr, nullptr);
    }
    GRID_SYNC(12);
    if (IN(13)) {
        pg8::Gemm g{XN, (const bf16*)(ws + WS_WGU2), D, D, D}; pg8::StaticOrder S; S.init(T, NGU, F.G, cblk, D, D);
        pg8::EpiSwiGLU E{HBb, DFF / 64};
        pg8::gemm_phase<pg8::EpiSwiGLU, pg8::StaticOrder, PG8_ALIGN, PG8_SP2>(F.lds + RING_OFF, g, S, E);
    }
    GRID_SYNC(13);
    if (IN(14)) {
        pg8::Gemm g{HBb, (const bf16*)(ws + WS_WD2), 64, 64, DFF, 256 * 64 * 2, 256 * 64 * 2}; pg8::StaticOrder S; S.init(T, D, F.G, cblk, 64, 64); S.apanel = (long)256 * DFF; S.bpanel = (long)256 * DFF;
        pg8::EpiBf16<0> E{Y, D, nullptr, 0, 0, 1.f};
        pg8::gemm_phase<pg8::EpiBf16<0>, pg8::StaticOrder, PG8_ALIGN, PG8_SP2>(F.lds + RING_OFF, g, S, E);
    }
    GRID_SYNC(14);
    if (IN(15)) {
        rowwise_res(F, Y, args.in[26], 0.5f, nullptr, XN, RINV, F.out, args.in[27]);
    }
#undef IN
#undef GRID_SYNC
}
__global__ void unpack_ofox(const bf16* Ob, float* omix) {
    const int t = blockIdx.x;
    for (int c = threadIdx.x; c < 1024; c += 256) omix[(size_t)t * D + c] = __builtin_bit_cast(float, (unsigned)Ob[(size_t)t * D + c] << 16);
}
constexpr int N_PHASES = 16;
extern "C" void kernel_launch(void* const* d_in, const int* in_sizes, int n_in, void* d_out, int out_size, void* d_ws, size_t ws_size, hipStream_t stream) {
    static int grid = 0;
    if (grid == 0) {
        int dev = 0, cus = 0;
        if (n_in != 28 || out_size != T * D || ws_size < WS_END) { fprintf(stderr, "kernel_launch: unexpected problem shape (n_in %d, out %d, ws %zu)\n", n_in, out_size, ws_size); grid = -1; return; }
        if (hipGetDevice(&dev) != hipSuccess || hipDeviceGetAttribute(&cus, hipDeviceAttributeMultiprocessorCount, dev) != hipSuccess) { fprintf(stderr, "kernel_launch: device query failed\n"); grid = -1; return; }
        if (hipFuncSetAttribute((const void*)mk_fwd, hipFuncAttributeMaxDynamicSharedMemorySize, LDS_BYTES) != hipSuccess) { fprintf(stderr, "kernel_launch: hipFuncSetAttribute failed\n"); grid = -1; return; }
        (void)hipGetLastError();
        int per_cu = 0;
        if (hipOccupancyMaxActiveBlocksPerMultiprocessor(&per_cu, (const void*)mk_fwd, NWAVES * 64, LDS_BYTES) != hipSuccess || per_cu < 1) { fprintf(stderr, "kernel_launch: occupancy query reports %d workgroups per CU\n", per_cu); (void)hipGetLastError(); per_cu = 1; }
        grid = cus;
        if (grid != 256) fprintf(stderr, "kernel_launch: %d CUs; this kernel is written for 256\n", grid);
    }
    if (grid < 0) return;
    Args a{};
    for (int i = 0; i < 28; ++i) a.in[i] = (const float*)d_in[i];
    a.out = (float*)d_out; a.ws = (unsigned char*)d_ws;
    if (hipMemsetAsync((char*)d_ws + WS_CTL, 0, CTL_ZERO_BYTES, stream) != hipSuccess) { fprintf(stderr, "kernel_launch: hipMemsetAsync failed\n"); return; }
    a.ph_lo = 0; a.ph_hi = N_PHASES;
    void* kargs[] = {(void*)&a};
    const hipError_t e = hipLaunchCooperativeKernel((const void*)mk_fwd, dim3(grid), dim3(NWAVES * 64), kargs, LDS_BYTES, stream);
    if (e != hipSuccess) fprintf(stderr, "kernel_launch: cooperative launch failed: %s (grid %d)\n", hipGetErrorString(e), grid);
}
```

```cpp
#include <hip/hip_runtime.h>
#include <hip/hip_cooperative_groups.h>
#include <hip/hip_bf16.h>
#include <cstdio>
#include <cstdint>
#include <cmath>
namespace pg8 {
#define PG8_LAS __attribute__((address_space(3)))
typedef unsigned short bf16_t;
typedef short bf16x8 __attribute__((ext_vector_type(8)));
typedef float f32x4 __attribute__((ext_vector_type(4)));
typedef unsigned u32x4 __attribute__((ext_vector_type(4)));
constexpr int BM = 256, BK = 64, HALF = 128, HTB = HALF * BK * 2  , STAGE_BYTES = 8 * HTB, NXCD = 8, WGM = 4;

__host__ __device__ __forceinline__ int lds_byte(int r, int c) { const int st = (r >> 4) * 2 + (c >> 5), rr = r & 15, cc = c & 31, ob = rr * 64 + cc * 2; return st * 1024 + (ob ^ (((ob >> 9) & 1) << 5)); }
__host__ __device__ __forceinline__ void stage_rc(int b, int& R, int& C) { const int st = b / 1024, sb = b % 1024, swz = sb ^ (((sb >> 9) & 1) << 5); R = (st >> 1) * 16 + swz / 64; C = (st & 1) * 32 + (swz % 64) / 2; }
__host__ __device__ __forceinline__ int perm32(int rho) { const int n = rho >> 4, i = rho & 15; return 8 * (i >> 2) + 4 * n + (i & 3); }

struct Unit { int pm, pn; long aoff, boff; };
struct Gemm { const bf16_t* A; const bf16_t* Bt; int lda, ldb, K; int kstepA = 0; int kstepB = 0; };

struct StaticOrder {
    int nM, nN, nwg, G, c, lda, ldb; int wgm = WGM; long apanel = 0; long bpanel = 0; long bbatch = 0; int i0 = 0, i1 = 1 << 30;
    __host__ __device__ void init(int M, int N, int G_, int c_, int lda_, int ldb_) { nM = M / BM; nN = N / BM; nwg = nM * nN; G = G_; c = c_; lda = lda_; ldb = ldb_; }
    __host__ __device__ __forceinline__ bool next(int i, Unit& u) const {
        if (i + i0 >= i1) return false;
        const long L = (long)(i + i0) * G + c; if (L >= nwg) return false;
        int wgid = (int)L; { const int q = nwg / NXCD, r = nwg % NXCD, xcd = wgid % NXCD, off = wgid / NXCD; wgid = (xcd < r ? xcd * (q + 1) : r * (q + 1) + (xcd - r) * q) + off; }
        const int nig = wgm * nN, gid = wgid / nig, fm = gid * wgm, gsz = (nM - fm) < wgm ? (nM - fm) : wgm;
        u.pm = fm + ((wgid % nig) % gsz); u.pn = (wgid % nig) / gsz; u.aoff = apanel ? (long)u.pm * apanel : (long)u.pm * BM * lda; u.boff = (bpanel ? (long)u.pn * bpanel : (long)u.pn * BM * ldb) + (long)(u.pm >> 4) * bbatch; return true;
    }
    __device__ __forceinline__ void a_ready(const Unit&) const {}
    __device__ __forceinline__ void done(const Unit&) const {}
};

__device__ __forceinline__ unsigned cvt_pk_bf16(float lo, float hi) { unsigned r; asm volatile("v_cvt_pk_bf16_f32 %0, %1, %2" : "=v"(r) : "v"(lo), "v"(hi)); return r; }
typedef float f32x2 __attribute__((ext_vector_type(2)));
__device__ __forceinline__ f32x2 gelu_pk(f32x2 v) {
    const f32x2 av = __builtin_elementwise_abs(v), d = av * 0.2316418882f + 1.0f;
    f32x2 t; t.x = __builtin_amdgcn_rcpf(d.x); t.y = __builtin_amdgcn_rcpf(d.y);
    f32x2 q = t * 0.5307027145f + (-0.7265760135f); q = q * t + 0.7107068705f; q = q * t + (-0.142248368f); q = q * t + 0.127414796f; q = q * t;
    const f32x2 s = (v * v) * (-0.72134752044f);
    f32x2 e; e.x = __builtin_amdgcn_exp2f(s.x); e.y = __builtin_amdgcn_exp2f(s.y);
    const f32x2 m = v * (q * e), r = v - m;
    f32x2 o; o.x = v.x < 0.f ? m.x : r.x; o.y = v.y < 0.f ? m.y : r.y; return o;
}

template <int ACT  > struct EpiBf16 {
    static constexpr bool PERM = true, AFTER_DRAIN = false; static_assert(ACT == 0 || ACT == 1, "EpiBf16: ACT is 0 (none) or 1 (gelu_pk)");
    bf16_t* O; int ldc; const float* bias; int split_cols; size_t split_stride; float scale0;
    __device__ __forceinline__ void operator()(const f32x4 (&acc)[2][2][4][2], const Unit& u, int wr, int wc, int fr, int fq) const {
        const int row0 = u.pm * BM + wr * 64 + fr; int colt = u.pn * BM; bf16_t* base = O;
        float sc = 1.f; if (split_cols) { const int t = colt / split_cols; base += (size_t)t * split_stride; colt -= t * split_cols; if (t == 0) sc = scale0; }
        const int col0 = colt + wc * 32 + 8 * fq, bcol0 = u.pn * BM + wc * 32 + 8 * fq;
        f32x4 bv[2][2];
#pragma unroll
        for (int bj = 0; bj < 2; ++bj)
#pragma unroll
            for (int n = 0; n < 2; ++n) bv[bj][n] = bias ? *(const f32x4*)(bias + bcol0 + bj * HALF + 4 * n) : (f32x4){0.f, 0.f, 0.f, 0.f};
#pragma unroll
        for (int ai = 0; ai < 2; ++ai)
#pragma unroll
            for (int m = 0; m < 4; ++m) { bf16_t* rowp = base + (size_t)(row0 + ai * HALF + m * 16) * ldc + col0;
#pragma unroll
                for (int bj = 0; bj < 2; ++bj) { f32x4 v0 = acc[ai][bj][m][0] + bv[bj][0], v1 = acc[ai][bj][m][1] + bv[bj][1];
                    if (ACT == 1) { f32x2 a = gelu_pk((f32x2){v0[0], v0[1]}), b = gelu_pk((f32x2){v0[2], v0[3]}), c = gelu_pk((f32x2){v1[0], v1[1]}), d = gelu_pk((f32x2){v1[2], v1[3]});
                        v0 = (f32x4){a.x, a.y, b.x, b.y}; v1 = (f32x4){c.x, c.y, d.x, d.y}; }
                    v0 = v0 * sc; v1 = v1 * sc; u32x4 w; w.x = cvt_pk_bf16(v0[0], v0[1]); w.y = cvt_pk_bf16(v0[2], v0[3]); w.z = cvt_pk_bf16(v1[0], v1[1]); w.w = cvt_pk_bf16(v1[2], v1[3]);
                    *(u32x4*)(rowp + bj * HALF) = w; } }
    }
};

struct PanelStats {
    unsigned* xbuf;
    unsigned* cnt;
    unsigned* tmo;
    int ntn; float eps;
    unsigned code;
    __device__ __forceinline__ bool run(const f32x4 (&v)[2][2][4][2], const Unit& u, int wr, int wc, int fr, int fq, PG8_LAS unsigned char* lds, int wid, int lane) const {
        typedef float f32x2v __attribute__((ext_vector_type(2)));
        PG8_LAS f32x2v* P = (PG8_LAS f32x2v*)lds;
        PG8_LAS f32x2v* S = (PG8_LAS f32x2v*)(lds + 8192);
        PG8_LAS unsigned* flag = (PG8_LAS unsigned*)(lds + 8192 + 2048);
#pragma unroll
        for (int ai = 0; ai < 2; ++ai)
#pragma unroll
            for (int m = 0; m < 4; ++m) {
                float s = 0.f;
#pragma unroll
                for (int bj = 0; bj < 2; ++bj)
#pragma unroll
                    for (int n = 0; n < 2; ++n) { const f32x4 x = v[ai][bj][m][n]; s += (x[0] + x[1]) + (x[2] + x[3]); }
                s += __shfl_xor(s, 16); s += __shfl_xor(s, 32);
                const float mw = s * (1.0f / 64.0f); float q = 0.f;
#pragma unroll
                for (int bj = 0; bj < 2; ++bj)
#pragma unroll
                    for (int n = 0; n < 2; ++n) { const f32x4 d = v[ai][bj][m][n] - mw; q += (d[0] * d[0] + d[1] * d[1]) + (d[2] * d[2] + d[3] * d[3]); }
                q += __shfl_xor(q, 16); q += __shfl_xor(q, 32);
                if (fq == 0) P[(ai * HALF + wr * 64 + m * 16 + fr) * 4 + wc] = (f32x2v){mw, q};
            }
        asm volatile("s_waitcnt lgkmcnt(0)" ::: "memory"); __builtin_amdgcn_s_barrier(); asm volatile("" ::: "memory");
#if defined(BROKEN_EXCHANGE_NO_WAIT)
#warning BROKEN CONTROL BUILD: the row-statistics exchange does not wait; results are wrong by design
        if (blockIdx.x >= 64) { const long long t0_ = clock64(); while (clock64() - t0_ < 60000) __builtin_amdgcn_s_sleep(8); }
#endif
        const int row = wid * 32 + (lane & 31);
        if (lane < 32) {
            const f32x2v a = P[row * 4 + 0], b = P[row * 4 + 1], c = P[row * 4 + 2], d = P[row * 4 + 3];
            const float mt = (a.x + b.x + c.x + d.x) * 0.25f;
            const float da = a.x - mt, db = b.x - mt, dc = c.x - mt, dd = d.x - mt;
            const float m2 = (a.y + b.y) + (c.y + d.y) + 64.0f * ((da * da + db * db) + (dc * dc + dd * dd));
            unsigned long long* slot = (unsigned long long*)xbuf + ((size_t)(u.pm * BM + row) * 4 + u.pn);
            __hip_atomic_store(slot, ((unsigned long long)__float_as_uint(m2) << 32) | __float_as_uint(mt), __ATOMIC_RELAXED, __HIP_MEMORY_SCOPE_AGENT);
        }
        asm volatile("s_waitcnt vmcnt(0)" ::: "memory");
        if (lane == 0) __hip_atomic_fetch_add(cnt + 64 * u.pm, 1u, __ATOMIC_RELAXED, __HIP_MEMORY_SCOPE_AGENT);
        if (wid == 0) {
            bool dead = false; const unsigned long long t0 = __builtin_amdgcn_s_memrealtime(); const unsigned want = 8u * (unsigned)ntn;
            for (;;) {
#if defined(BROKEN_EXCHANGE_NO_WAIT)
                break;
#endif
                if ((unsigned)__builtin_amdgcn_readfirstlane(__hip_atomic_load(cnt + 64 * u.pm, __ATOMIC_RELAXED, __HIP_MEMORY_SCOPE_AGENT)) >= want) break;
                if (__builtin_amdgcn_s_memrealtime() - t0 > 2000000ull) {
                    if (lane == 0) { unsigned expect = 0u; __hip_atomic_compare_exchange_strong(tmo + 1, &expect, code | (unsigned)(u.pm & 0xff), __ATOMIC_RELAXED, __ATOMIC_RELAXED, __HIP_MEMORY_SCOPE_AGENT);
                                     __hip_atomic_store(tmo, 1u, __ATOMIC_RELAXED, __HIP_MEMORY_SCOPE_AGENT); }
                    dead = true; break; }
                __builtin_amdgcn_s_sleep(2);
            }
            __builtin_amdgcn_fence(__ATOMIC_ACQUIRE, "agent");
            if (lane == 0) flag[0] = dead ? 1u : 0u;
        }
        asm volatile("s_waitcnt vmcnt(0) lgkmcnt(0)" ::: "memory"); __builtin_amdgcn_s_barrier(); asm volatile("" ::: "memory");
        const bool bad = flag[0] != 0u;
        if (lane < 32) {
            const unsigned long long* slot = (const unsigned long long*)xbuf + (size_t)(u.pm * BM + row) * 4; float mt[4], m2[4]; float ms = 0.f;
#pragma unroll
            for (int t = 0; t < 4; ++t) { if (t < ntn) { const unsigned long long w = __hip_atomic_load(slot + t, __ATOMIC_RELAXED, __HIP_MEMORY_SCOPE_AGENT); mt[t] = __uint_as_float((unsigned)w); m2[t] = __uint_as_float((unsigned)(w >> 32)); } else { mt[t] = 0.f; m2[t] = 0.f; } ms += mt[t]; }
            const float mean = ms / (float)ntn; float q = 0.f;
#pragma unroll
            for (int t = 0; t < 4; ++t) if (t < ntn) { const float dm = mt[t] - mean; q += m2[t] + 256.0f * dm * dm; }
            S[row] = (f32x2v){mean, 1.0f / sqrtf(q / (256.0f * (float)ntn) + eps)};
        }
        asm volatile("s_waitcnt lgkmcnt(0)" ::: "memory"); __builtin_amdgcn_s_barrier(); asm volatile("" ::: "memory");
        return bad;
    }
};
struct EpiLnRes {
    static constexpr bool PERM = false, AFTER_DRAIN = true;
    const float* base; float* out; int ldc; const float* bias; PanelStats st; unsigned poison;
    __device__ __forceinline__ void fused(f32x4 (&acc)[2][2][4][2], const Unit& u, int wr, int wc, int fr, int fq, PG8_LAS unsigned char* lds, int wid, int lane) const {
        typedef float f32x2v __attribute__((ext_vector_type(2)));
        const PG8_LAS f32x2v* S = (const PG8_LAS f32x2v*)(lds + 8192);
        const int col0 = u.pn * BM + wc * 32 + 4 * fq;
#pragma unroll
        for (int bj = 0; bj < 2; ++bj)
#pragma unroll
            for (int n = 0; n < 2; ++n) { const f32x4 bv = bias ? *(const f32x4*)(bias + col0 + bj * HALF + n * 16) : (f32x4){0.f, 0.f, 0.f, 0.f};
#pragma unroll
                for (int ai = 0; ai < 2; ++ai)
#pragma unroll
                    for (int m = 0; m < 4; ++m) acc[ai][bj][m][n] += bv; }
        f32x4 pre[4][2][2];
#pragma unroll
        for (int m = 0; m < 4; ++m) { const size_t off = (size_t)(u.pm * BM + wr * 64 + m * 16 + fr) * ldc + col0;
#pragma unroll
            for (int bj = 0; bj < 2; ++bj)
#pragma unroll
                for (int n = 0; n < 2; ++n) pre[m][bj][n] = *(const f32x4*)(base + off + bj * HALF + n * 16); }
        const bool bad = st.run(acc, u, wr, wc, fr, fq, lds, wid, lane) || poison != 0u;
        const float qnan = __builtin_nanf("");
#pragma unroll
        for (int ai = 0; ai < 2; ++ai)
#pragma unroll
            for (int m = 0; m < 4; ++m) { const int r = ai * HALF + wr * 64 + m * 16 + fr; const f32x2v sr = S[r]; const size_t off = (size_t)(u.pm * BM + r) * ldc + col0;
#pragma unroll
                for (int bj = 0; bj < 2; ++bj)
#pragma unroll
                    for (int n = 0; n < 2; ++n) { const f32x4 bs = ai == 0 ? pre[m][bj][n] : *(const f32x4*)(base + off + bj * HALF + n * 16); f32x4 o = bs + (acc[ai][bj][m][n] - sr.x) * sr.y;
                        if (bad) o = (f32x4){qnan, qnan, qnan, qnan}; *(f32x4*)(out + off + bj * HALF + n * 16) = o; }
                if (m & 1) asm volatile("" ::: "memory"); }
    }
};
struct EpiLnResLn {
    static constexpr bool PERM = false, AFTER_DRAIN = true;
    const float* base; float* out; bf16_t* xn; int ldc; const float* bias; PanelStats st1, st2; unsigned poison;
    __device__ __forceinline__ void fused(f32x4 (&acc)[2][2][4][2], const Unit& u, int wr, int wc, int fr, int fq, PG8_LAS unsigned char* lds, int wid, int lane) const {
        typedef float f32x2v __attribute__((ext_vector_type(2))); typedef unsigned u32x2v __attribute__((ext_vector_type(2)));
        const PG8_LAS f32x2v* S = (const PG8_LAS f32x2v*)(lds + 8192);
        const int col0 = u.pn * BM + wc * 32 + 4 * fq;
#pragma unroll
        for (int bj = 0; bj < 2; ++bj)
#pragma unroll
            for (int n = 0; n < 2; ++n) { const f32x4 bv = bias ? *(const f32x4*)(bias + col0 + bj * HALF + n * 16) : (f32x4){0.f, 0.f, 0.f, 0.f};
#pragma unroll
                for (int ai = 0; ai < 2; ++ai)
#pragma unroll
                    for (int m = 0; m < 4; ++m) acc[ai][bj][m][n] += bv; }
        bool bad = st1.run(acc, u, wr, wc, fr, fq, lds, wid, lane) || poison != 0u;
        const float qnan = __builtin_nanf("");
#pragma unroll
        for (int ai = 0; ai < 2; ++ai)
#pragma unroll
            for (int m = 0; m < 4; ++m) { const int r = ai * HALF + wr * 64 + m * 16 + fr; const f32x2v sr = S[r]; const size_t off = (size_t)(u.pm * BM + r) * ldc + col0;
#pragma unroll
                for (int bj = 0; bj < 2; ++bj)
#pragma unroll
                    for (int n = 0; n < 2; ++n) { const f32x4 bs = *(const f32x4*)(base + off + bj * HALF + n * 16); acc[ai][bj][m][n] = bs + (acc[ai][bj][m][n] - sr.x) * sr.y; }
                asm volatile("" : "+v"(acc[ai][0][m][0]), "+v"(acc[ai][0][m][1]), "+v"(acc[ai][1][m][0]), "+v"(acc[ai][1][m][1]));
                if (m & 1) asm volatile("" ::: "memory"); }
        const bool bad1 = bad;
        bad = st2.run(acc, u, wr, wc, fr, fq, lds, wid, lane) || bad;
#pragma unroll
        for (int ai = 0; ai < 2; ++ai)
#pragma unroll
            for (int m = 0; m < 4; ++m) { const int r = ai * HALF + wr * 64 + m * 16 + fr; const f32x2v sr = S[r]; const size_t off = (size_t)(u.pm * BM + r) * ldc + col0;
#pragma unroll
                for (int bj = 0; bj < 2; ++bj)
#pragma unroll
                    for (int n = 0; n < 2; ++n) { const f32x4 x1 = acc[ai][bj][m][n]; *(f32x4*)(out + off + bj * HALF + n * 16) = bad1 ? (f32x4){qnan, qnan, qnan, qnan} : x1;
                        const f32x4 o = (x1 - sr.x) * sr.y; u32x2v w; w.x = cvt_pk_bf16(o[0], o[1]); w.y = cvt_pk_bf16(o[2], o[3]);
                        if (bad) { w.x = 0x7fc07fc0u; w.y = 0x7fc07fc0u; } *(u32x2v*)(xn + off + bj * HALF + n * 16) = w; }
                asm volatile("" ::: "memory"); }
    }
};

template <class Epi, class Sched, bool ALIGN_EPI = false, bool SP2 = false>
__device__ __forceinline__ void gemm_phase(PG8_LAS unsigned char* lds, const Gemm g, const Sched& S, const Epi& E) {
    const int tid = threadIdx.x, wid = __builtin_amdgcn_readfirstlane(tid >> 6), lane = tid & 63, wr = wid >> 2, wc = wid & 3, fr = lane & 15, fq = lane >> 4;
    const int K = g.K, nt = K / BK;
    unsigned voffA[2], voffB[2];
#pragma unroll
    for (int i = 0; i < 2; ++i) { int R, C; stage_rc(tid * 16 + i * 8192, R, C); const int Rb = Epi::PERM ? ((R & ~31) + perm32(R & 31)) : R;
        voffA[i] = (unsigned)(R * g.lda + C) * 2u; voffB[i] = (unsigned)(Rb * g.ldb + C) * 2u; }
    const size_t kstepB = g.kstepB ? (size_t)g.kstepB : (size_t)(BK * 2), kstepA = g.kstepA ? (size_t)g.kstepA : (size_t)(BK * 2);
    const size_t hstepA = (size_t)HALF * g.lda * 2, hstepB = (size_t)HALF * g.ldb * 2;
    const unsigned ldsw = (unsigned)wid * 1024u;
    const int aoff = lds_byte(wr * 64 + fr, fq * 8), boff = lds_byte(wc * 32 + fr, fq * 8);
#define PG8_SA(b, h) (((b) * 2 + (h)) * HTB)
#define PG8_SB(b, h) ((4 + (b) * 2 + (h)) * HTB)
#define PG8_STAGE(bufoff, gbase, voff) do { _Pragma("unroll") for (int _i = 0; _i < 2; ++_i) \
        __builtin_amdgcn_global_load_lds((const unsigned*)((const char*)(gbase) + (voff)[_i]), (PG8_LAS unsigned*)(lds + (bufoff) + ldsw + _i * 8192), 16, 0, 0); } while (0)
#define PG8_LDA(dst, b, h) do { _Pragma("unroll") for (int m = 0; m < 4; ++m) _Pragma("unroll") for (int k = 0; k < 2; ++k) dst[m][k] = *(const PG8_LAS bf16x8*)(lds + PG8_SA(b, h) + aoff + m * 2048 + k * 1024); } while (0)
#define PG8_LDB(dst, b, h) do { _Pragma("unroll") for (int n = 0; n < 2; ++n) _Pragma("unroll") for (int k = 0; k < 2; ++k) dst[n][k] = *(const PG8_LAS bf16x8*)(lds + PG8_SB(b, h) + boff + n * 2048 + k * 1024); } while (0)
#define PG8_MMA(ai, bj, At, Bt) do { __builtin_amdgcn_s_setprio(1); _Pragma("unroll") for (int m = 0; m < 4; ++m) _Pragma("unroll") for (int n = 0; n < 2; ++n) _Pragma("unroll") for (int k = 0; k < 2; ++k) \
        acc[ai][bj][m][n] = __builtin_amdgcn_mfma_f32_16x16x32_bf16(Bt[n][k], At[m][k], acc[ai][bj][m][n], 0, 0, 0); __builtin_amdgcn_s_setprio(0); } while (0)
#define PG8_WAIT_V(n) asm volatile("s_waitcnt vmcnt(" #n ")" ::: "memory")
#define PG8_WAIT_L(n) asm volatile("s_waitcnt lgkmcnt(" #n ")" ::: "memory")
#define PG8_BAR __builtin_amdgcn_s_barrier()
#define PG8_SCHED __builtin_amdgcn_sched_barrier(0)
    Unit cur, nxt; int ui = 0;
    if (!S.next(0, cur)) return;
    f32x4 acc[2][2][4][2];
#pragma unroll
    for (int a = 0; a < 2; ++a)
#pragma unroll
        for (int b = 0; b < 2; ++b)
#pragma unroll
            for (int m = 0; m < 4; ++m)
#pragma unroll
                for (int n = 0; n < 2; ++n) acc[a][b][m][n] = (f32x4){0.f, 0.f, 0.f, 0.f};
    bf16x8 At[4][2], B0[2][2], B1[2][2];
    const char* cA = (const char*)(g.A + cur.aoff); const char* cB = (const char*)(g.Bt + cur.boff);
    S.a_ready(cur);
    if constexpr (SP2) {
        PG8_STAGE(PG8_SB(0, 0), cB, voffB); PG8_STAGE(PG8_SB(0, 1), cB + hstepB, voffB); PG8_STAGE(PG8_SA(0, 0), cA, voffA); PG8_STAGE(PG8_SA(0, 1), cA + hstepA, voffA);
        if (wr == 1) PG8_BAR;
        PG8_WAIT_V(2); PG8_BAR;
        PG8_STAGE(PG8_SB(1, 0), cB + kstepB, voffB); PG8_STAGE(PG8_SA(1, 0), cA + kstepA, voffA); PG8_STAGE(PG8_SB(1, 1), cB + hstepB + kstepB, voffB);
        PG8_WAIT_V(6); PG8_BAR;
    } else {
        PG8_STAGE(PG8_SB(0, 0), cB, voffB); PG8_STAGE(PG8_SA(0, 0), cA, voffA); PG8_STAGE(PG8_SB(0, 1), cB + hstepB, voffB); PG8_STAGE(PG8_SA(0, 1), cA + hstepA, voffA);
        if (wr == 1) PG8_BAR;
        PG8_WAIT_V(4); PG8_BAR;
        PG8_STAGE(PG8_SB(1, 0), cB + kstepB, voffB); PG8_STAGE(PG8_SA(1, 0), cA + kstepA, voffA); PG8_STAGE(PG8_SB(1, 1), cB + hstepB + kstepB, voffB);
        PG8_WAIT_V(6); PG8_BAR;
    }
    for (;;) {
        const bool has_next = S.next(ui + 1, nxt);
        const char* nA = has_next ? (const char*)(g.A + nxt.aoff) : cA; const char* nB = has_next ? (const char*)(g.Bt + nxt.boff) : cB;
        for (int t = 0; t < nt; t += 2) {
            const bool last = (t == nt - 2);
            const char* a1 = cA + (size_t)(t + 1) * kstepA;
            const char* a2 = last ? nA : cA + (size_t)(t + 2) * kstepA; const char* b2 = last ? nB : cB + (size_t)(t + 2) * kstepB;
            const char* a3 = a2 + kstepA; const char* b3 = b2 + kstepB;
            if (last && has_next) S.a_ready(nxt);
            if constexpr (SP2) {
            PG8_LDB(B0, 0, 0); PG8_LDB(B1, 0, 1); PG8_SCHED; PG8_LDA(At, 0, 0); PG8_STAGE(PG8_SA(1, 1), a1 + hstepA, voffA);
            PG8_WAIT_V(8); PG8_WAIT_L(0); PG8_BAR; PG8_MMA(0, 0, At, B0); PG8_MMA(0, 1, At, B1); PG8_BAR; PG8_SCHED;
            PG8_LDA(At, 0, 1); PG8_STAGE(PG8_SB(0, 0), b2, voffB); PG8_STAGE(PG8_SB(0, 1), b2 + hstepB, voffB); PG8_STAGE(PG8_SA(0, 0), a2, voffA);
            PG8_WAIT_V(8); PG8_WAIT_L(0); PG8_BAR; PG8_MMA(1, 0, At, B0); PG8_MMA(1, 1, At, B1); PG8_BAR; PG8_SCHED;
            PG8_LDB(B0, 1, 0); PG8_LDB(B1, 1, 1); PG8_SCHED; PG8_LDA(At, 1, 0); PG8_STAGE(PG8_SA(0, 1), a2 + hstepA, voffA);
            PG8_WAIT_V(8); PG8_WAIT_L(0); PG8_BAR; PG8_MMA(0, 0, At, B0); PG8_MMA(0, 1, At, B1); PG8_BAR; PG8_SCHED;
            PG8_LDA(At, 1, 1); PG8_STAGE(PG8_SB(1, 0), b3, voffB); PG8_STAGE(PG8_SB(1, 1), b3 + hstepB, voffB); PG8_STAGE(PG8_SA(1, 0), a3, voffA);
            PG8_WAIT_V(8); PG8_WAIT_L(0); PG8_BAR; PG8_MMA(1, 0, At, B0); PG8_MMA(1, 1, At, B1); PG8_BAR; PG8_SCHED;
            } else {
            PG8_LDB(B0, 0, 0); PG8_SCHED; PG8_LDA(At, 0, 0); PG8_STAGE(PG8_SA(1, 1), a1 + hstepA, voffA);
            PG8_WAIT_L(8); PG8_BAR; PG8_WAIT_L(0); PG8_MMA(0, 0, At, B0); PG8_BAR; PG8_SCHED;
            PG8_LDB(B1, 0, 1); PG8_STAGE(PG8_SB(0, 0), b2, voffB);
            PG8_BAR; PG8_WAIT_L(0); PG8_MMA(0, 1, At, B1); PG8_BAR;
            PG8_LDA(At, 0, 1); PG8_STAGE(PG8_SA(0, 0), a2, voffA);
            PG8_BAR; PG8_WAIT_L(0); PG8_MMA(1, 0, At, B0); PG8_BAR; PG8_SCHED;
            PG8_STAGE(PG8_SB(0, 1), b2 + hstepB, voffB);
            PG8_WAIT_V(6); PG8_BAR; PG8_MMA(1, 1, At, B1); PG8_BAR;
            PG8_LDB(B0, 1, 0); PG8_SCHED; PG8_LDA(At, 1, 0); PG8_STAGE(PG8_SA(0, 1), a2 + hstepA, voffA);
            PG8_WAIT_L(8); PG8_BAR; PG8_WAIT_L(0); PG8_MMA(0, 0, At, B0); PG8_BAR; PG8_SCHED;
            PG8_LDB(B1, 1, 1); PG8_STAGE(PG8_SB(1, 0), b3, voffB);
            PG8_BAR; PG8_WAIT_L(0); PG8_MMA(0, 1, At, B1); PG8_BAR;
            PG8_LDA(At, 1, 1); PG8_STAGE(PG8_SA(1, 0), a3, voffA);
            PG8_BAR; PG8_WAIT_L(0); PG8_MMA(1, 0, At, B0); PG8_BAR; PG8_SCHED;
            PG8_STAGE(PG8_SB(1, 1), b3 + hstepB, voffB);
            PG8_WAIT_V(6); PG8_BAR; PG8_MMA(1, 1, At, B1); PG8_BAR;
            }
        }
        if constexpr (ALIGN_EPI) { if (wr == 0) PG8_BAR; }
        if constexpr (!Epi::AFTER_DRAIN) { E(acc, cur, wr, wc, fr, fq); S.done(cur); }
        if (!has_next) break;
#pragma unroll
        for (int a = 0; a < 2; ++a)
#pragma unroll
            for (int b = 0; b < 2; ++b)
#pragma unroll
                for (int m = 0; m < 4; ++m)
#pragma unroll
                    for (int n = 0; n < 2; ++n) acc[a][b][m][n] = (f32x4){0.f, 0.f, 0.f, 0.f};
        cur = nxt; cA = nA; cB = nB; ++ui;
        if constexpr (ALIGN_EPI) { if (wr == 1) PG8_BAR; }
    }
    PG8_WAIT_V(0);
    if constexpr (!ALIGN_EPI) { if (wr == 0) PG8_BAR; }
    PG8_BAR;
    if constexpr (Epi::AFTER_DRAIN) { E.fused(acc, cur, wr, wc, fr, fq, lds, wid, lane); S.done(cur); }
#undef PG8_SA
#undef PG8_SB
#undef PG8_STAGE
#undef PG8_LDA
#undef PG8_LDB
#undef PG8_MMA
#undef PG8_WAIT_V
#undef PG8_WAIT_L
#undef PG8_BAR
#undef PG8_SCHED
}
}
namespace pg8 {
struct EpiSwiGLU {
    static constexpr bool PERM = true, AFTER_DRAIN = false;
    bf16_t* O; int nkt;
    __device__ __forceinline__ void operator()(const f32x4 (&acc)[2][2][4][2], const Unit& u, int wr, int wc, int fr, int fq) const {
        bf16_t* base = O + ((size_t)(u.pm * nkt + 2 * u.pn + (wc >> 1)) * 256 + wr * 64 + fr) * 64 + 32 * (wc & 1) + 8 * fq;
#pragma unroll
        for (int ai = 0; ai < 2; ++ai)
#pragma unroll
            for (int m = 0; m < 4; ++m) {
                float h[8];
#pragma unroll
                for (int n = 0; n < 2; ++n)
#pragma unroll
                    for (int i = 0; i < 4; ++i) { const float g = acc[ai][0][m][n][i], up = acc[ai][1][m][n][i];
                        h[n * 4 + i] = g * __builtin_amdgcn_rcpf(1.0f + __builtin_amdgcn_exp2f(-1.4426950408889634f * g)) * up; }
                u32x4 w; w.x = cvt_pk_bf16(h[0], h[1]); w.y = cvt_pk_bf16(h[2], h[3]); w.z = cvt_pk_bf16(h[4], h[5]); w.w = cvt_pk_bf16(h[6], h[7]);
                *(u32x4*)(base + (size_t)(ai * HALF + m * 16) * 64) = w;
            }
    }
};
struct EpiF32 {
    static constexpr bool PERM = false, AFTER_DRAIN = false;
    float* O; int ldc;
    __device__ __forceinline__ void operator()(const f32x4 (&acc)[2][2][4][2], const Unit& u, int wr, int wc, int fr, int fq) const {
        const int row0 = u.pm * BM + wr * 64 + fr, col0 = u.pn * BM + wc * 32 + 4 * fq;
#pragma unroll
        for (int ai = 0; ai < 2; ++ai)
#pragma unroll
            for (int m = 0; m < 4; ++m) { float* rowp = O + (size_t)(row0 + ai * HALF + m * 16) * ldc + col0;
#pragma unroll
                for (int bj = 0; bj < 2; ++bj)
#pragma unroll
                    for (int n = 0; n < 2; ++n) *(f32x4*)(rowp + bj * HALF + n * 16) = acc[ai][bj][m][n]; }
    }
};
struct EpiSoftmax {
    static constexpr bool PERM = true, AFTER_DRAIN = false;
    bf16_t* O; int ldc; PG8_LAS float* tab;
    __device__ __forceinline__ void operator()(f32x4 (&acc)[2][2][4][2], const Unit& u, int wr, int wc, int fr, int fq) const {
#pragma unroll
        for (int ai = 0; ai < 2; ++ai)
#pragma unroll
            for (int m = 0; m < 4; ++m) { float s = 0.f;
#pragma unroll
                for (int bj = 0; bj < 2; ++bj)
#pragma unroll
                    for (int n = 0; n < 2; ++n) { f32x4 p; p[0] = __builtin_amdgcn_exp2f(acc[ai][bj][m][n][0]); p[1] = __builtin_amdgcn_exp2f(acc[ai][bj][m][n][1]);
                        p[2] = __builtin_amdgcn_exp2f(acc[ai][bj][m][n][2]); p[3] = __builtin_amdgcn_exp2f(acc[ai][bj][m][n][3]); acc[ai][bj][m][n] = p; s += (p[0] + p[1]) + (p[2] + p[3]); }
                s += __shfl_xor(s, 16); s += __shfl_xor(s, 32);
                if (fq == 0) tab[(ai * HALF + wr * 64 + m * 16 + fr) * 4 + wc] = s; }
        asm volatile("s_waitcnt lgkmcnt(0)" ::: "memory"); __builtin_amdgcn_s_barrier(); asm volatile("" ::: "memory");
        const int row0 = u.pm * BM + wr * 64 + fr, col0 = u.pn * BM + wc * 32 + 8 * fq;
#pragma unroll
        for (int ai = 0; ai < 2; ++ai)
#pragma unroll
            for (int m = 0; m < 4; ++m) { const f32x4 t = *(const PG8_LAS f32x4*)(tab + (ai * HALF + wr * 64 + m * 16 + fr) * 4);
                const float inv = __builtin_amdgcn_rcpf((t[0] + t[1]) + (t[2] + t[3]));
                bf16_t* rowp = O + (size_t)(row0 + ai * HALF + m * 16) * ldc + col0;
#pragma unroll
                for (int bj = 0; bj < 2; ++bj) { const f32x4 v0 = acc[ai][bj][m][0] * inv, v1 = acc[ai][bj][m][1] * inv;
                    u32x4 w; w.x = cvt_pk_bf16(v0[0], v0[1]); w.y = cvt_pk_bf16(v0[2], v0[3]); w.z = cvt_pk_bf16(v1[0], v1[1]); w.w = cvt_pk_bf16(v1[2], v1[3]);
                    *(u32x4*)(rowp + bj * HALF) = w; } }
        asm volatile("s_waitcnt lgkmcnt(0)" ::: "memory"); __builtin_amdgcn_s_barrier(); asm volatile("" ::: "memory");
    }
};
}
constexpr int NWAVES = 8;
constexpr int NB = 8, SEQ = 4096, T = NB * SEQ, D = 1024, DFF = 2816, NGU = 2 * DFF, ZW = 3072, ML = 256, INW = 3096;
constexpr float RMS_EPS = 1e-6f;
constexpr float LOG2E = 1.4426950408889634f;
constexpr float C2 = 0.125f * LOG2E;
constexpr size_t MiB = 1u << 20;
constexpr size_t WS_CTL = 0, CTL_ZERO_BYTES = 1 * MiB;
constexpr size_t WS_WGU1 = 1 * MiB, WS_WD1 = 12 * MiB, WS_WGU2 = 18 * MiB, WS_WD2 = 29 * MiB, WS_WIN = 35 * MiB, WS_WSM = 41 * MiB, WS_WOUT = 42 * MiB,
                 WS_WQRM = 44 * MiB, WS_WKVT = 46 * MiB, WS_WOT = 50 * MiB, WS_MN = 52 * MiB, WS_KVM = 56 * MiB, WS_ZSM = 64 * MiB, WS_CLOC = 68 * MiB, WS_TOT = 69 * MiB;
constexpr size_t WS_XN = 72 * MiB, WS_BIG = 136 * MiB, WS_XNB = 328 * MiB, WS_Y = 392 * MiB, WS_END = 512 * MiB;
constexpr size_t WS_RINV = 70 * MiB;
constexpr size_t BIG_SLICE = 24 * MiB, SL_WQK = 8 * MiB, SL_VWOT = 10 * MiB, Y_SLICE = 8 * MiB;
constexpr int RING_OFF = 0, RING_BYTES = 131072, LDSCTL_OFF = RING_BYTES, MISC_OFF = LDSCTL_OFF + 320, LDS_BYTES = 147456;
constexpr int TAB_OFF = RING_BYTES + 1024;

#define GAS __attribute__((address_space(1)))
#define LAS __attribute__((address_space(3)))
typedef unsigned short bf16;
typedef unsigned v4u __attribute__((ext_vector_type(4)));
typedef unsigned v2u __attribute__((ext_vector_type(2)));
typedef float f32x4 __attribute__((ext_vector_type(4)));
typedef short bf16x8 __attribute__((ext_vector_type(8)));
#define LDS_WAIT() asm volatile("s_waitcnt lgkmcnt(0)" ::: "memory")
#define VM_WAIT() asm volatile("s_waitcnt vmcnt(0)" ::: "memory")
__device__ __forceinline__ unsigned f2bf(float f) { unsigned u = __builtin_bit_cast(unsigned, f); return (u + 0x7fffu + ((u >> 16) & 1u)) >> 16; }
__device__ __forceinline__ unsigned pk2(float lo, float hi) { return f2bf(lo) | (f2bf(hi) << 16); }
__device__ __forceinline__ float wave_sum(float v) {
#pragma unroll
    for (int o = 1; o < 64; o <<= 1) v += __shfl_xor(v, o);
    return v;
}

typedef GAS unsigned gu32;
#define RLX_AGENT __ATOMIC_RELAXED, __HIP_MEMORY_SCOPE_AGENT
constexpr int CW_BAR = 4096;
#define XB_TMO      128
#define XB_XCNT(j)  (256  + 64 * (j))
#define XB_XSUB(j)  (1280 + 64 * (j))
#define XB_XGEN(j)  (2304 + 64 * (j))
#define XB_TOP      3328
#define XB_TOPGEN   3392
#define XCD_BAR_WORDS 3456
#define XB_SPIN_CAP (1u << 18)

__device__ __forceinline__ unsigned xb_ld(unsigned* p)              { return __hip_atomic_load(p, __ATOMIC_RELAXED, __HIP_MEMORY_SCOPE_AGENT); }
__device__ __forceinline__ unsigned xb_add(unsigned* p, unsigned v) { return __hip_atomic_fetch_add(p, v, __ATOMIC_RELAXED, __HIP_MEMORY_SCOPE_AGENT); }
__device__ __forceinline__ unsigned xb_xcc_id() { return (unsigned)__builtin_amdgcn_s_getreg((3 << 11) | 20) & 0xFu; }
#define XB_SPIN(cond, bar) do { unsigned _sp = 0; while (cond) { __builtin_amdgcn_s_sleep(1); \
    if ((++_sp & 255u) == 0u) { if (xb_ld(&(bar)[XB_TMO])) break; if (_sp > XB_SPIN_CAP) { atomicAdd(&(bar)[XB_TMO], 1u); break; } } } } while (0)

struct XcdBarrier {
    unsigned* bar; unsigned x;
    volatile LAS unsigned* st;
};

__device__ __forceinline__ XcdBarrier xcd_barrier_post(unsigned* bar, volatile LAS unsigned* st) {
    XcdBarrier b; b.bar = bar; b.x = xb_xcc_id(); b.st = st;
    if (threadIdx.x == 0) (void)xb_add(&bar[XB_XCNT(b.x)], 1u);
    return b;
}
__device__ __forceinline__ void xcd_barrier_complete(unsigned* bar, unsigned x, unsigned& nloc, unsigned& nx) {
    const unsigned G = gridDim.x * gridDim.y * gridDim.z;
    unsigned sum, cnt, mine, sp = 0u;
    for (;;) {
        sum = 0u; cnt = 0u; mine = 0u;
#pragma unroll
        for (unsigned j = 0; j < 16; ++j) { const unsigned c = xb_ld(&bar[XB_XCNT(j)]); sum += c; cnt += (c > 0u) ? 1u : 0u; mine = (j == x) ? c : mine; }
        if (sum == G) break;
        __builtin_amdgcn_s_sleep(1);
        if ((++sp & 255u) == 0u) { if (xb_ld(&bar[XB_TMO])) break; if (sp > XB_SPIN_CAP) { atomicAdd(&bar[XB_TMO], 1u); break; } }
    }
    nloc = mine > 0u ? mine : 1u; nx = cnt > 0u ? cnt : 1u;
}

__device__ __forceinline__ void xcd_barrier(const XcdBarrier& b) {
    asm volatile("s_waitcnt vmcnt(0)" ::: "memory");
    __syncthreads();
    if (threadIdx.x == 0) {
        unsigned* bar = b.bar;
        __builtin_amdgcn_s_waitcnt(0);
        unsigned nloc = b.st[0], nx = b.st[1];
        if (nloc == 0u) { xcd_barrier_complete(bar, b.x, nloc, nx); b.st[0] = nloc; b.st[1] = nx; }
        const unsigned old = xb_add(&bar[XB_XSUB(b.x)], 1u);
        const unsigned gen = old / nloc;
        if (old + 1u == (gen + 1u) * nloc) {
            __builtin_amdgcn_fence(__ATOMIC_RELEASE, "agent");
            asm volatile("s_waitcnt vmcnt(0)" ::: "memory");
            const unsigned og = xb_add(&bar[XB_TOP], 1u);
            const unsigned tg = og / nx;
            if (og + 1u == (tg + 1u) * nx) xb_add(&bar[XB_TOPGEN], 1u);
            else XB_SPIN(xb_ld(&bar[XB_TOPGEN]) == tg, bar);
            __builtin_amdgcn_fence(__ATOMIC_ACQUIRE, "agent");
            xb_add(&bar[XB_XGEN(b.x)], 1u);
            asm volatile("s_waitcnt vmcnt(0)" ::: "memory");
        } else {
            XB_SPIN(xb_ld(&bar[XB_XGEN(b.x)]) == gen, bar);
            __builtin_amdgcn_fence(__ATOMIC_ACQUIRE, "agent");
            asm volatile("s_waitcnt vmcnt(0)" ::: "memory");
        }
    }
    __syncthreads();
}

struct Frame {
    LAS unsigned char* lds;
    int tid, lane, wave, vcu, G;
    const float* const* in;
    const float* x; float* out; unsigned char* ws;
};
struct Args { const float* in[28]; float* out; unsigned char* ws; int ph_lo, ph_hi; };

struct SegC { int win, ldw, K, src0, ncols, dst0, il, gin; float cs; unsigned wsoff; int blk; };
__host__ __device__ constexpr SegC seg_c(int s) {
    constexpr SegC T_[] = {
    {3, DFF, D, 0, DFF, 0, 1, 2, 1.f, (unsigned)WS_WGU1}, {4, DFF, D, 0, DFF, 128, 1, 2, 1.f, (unsigned)WS_WGU1}, {5, D, DFF, 0, D, 0, 0, -1, 1.f, (unsigned)WS_WD1, 1},
    {23, DFF, D, 0, DFF, 0, 1, 22, 1.f, (unsigned)WS_WGU2}, {24, DFF, D, 0, DFF, 128, 1, 22, 1.f, (unsigned)WS_WGU2}, {25, D, DFF, 0, D, 0, 0, -1, 1.f, (unsigned)WS_WD2, 1},
    {8, INW, D, 0, 512, 0, 0, 7, C2, (unsigned)WS_WIN}, {8, INW, D, 512, 512, 512, 0, 7, 1.f, (unsigned)WS_WIN}, {8, INW, D, 1024, 512, 1024, 0, 7, 1.f, (unsigned)WS_WIN},
    {8, INW, D, 1544, 256, 1536, 0, 7, 0.125f, (unsigned)WS_WIN}, {8, INW, D, 1800, 256, 1792, 0, 7, 1.f, (unsigned)WS_WIN}, {8, INW, D, 2056, 512, 2048, 0, 7, 1.f, (unsigned)WS_WIN},
    {8, INW, D, 2584, 512, 2560, 0, 7, 1.f, (unsigned)WS_WIN},
    {14, D, D, 0, D, 0, 0, -1, 1.f, (unsigned)WS_WOUT}, {19, 2048, D, 0, 2048, 0, 0, 17, 1.f, (unsigned)WS_WKVT}, {20, D, D, 0, D, 0, 0, -1, 1.f, (unsigned)WS_WOT},
};
    return T_[s];
}
constexpr int NSEG = 16;

__device__ __forceinline__ void tr_item(const float* __restrict__ W, int ldw, int k0, int ns0, int nvalid, bf16* __restrict__ WT, int ldk, int dst0, int il, const float* __restrict__ gk, float cs, int lane, int blk) {
    const int n = 4 * lane;
    if (n >= nvalid) return;
    const float* src = W + (size_t)k0 * ldw + ns0 + n;
    f32x4 v[1][8];
#pragma unroll
    for (int kb = 0; kb < 1; ++kb)
#pragma unroll
        for (int j = 0; j < 8; ++j) v[kb][j] = __builtin_nontemporal_load((const f32x4*)(src + (size_t)(kb * 8 + j) * ldw));
#pragma unroll
    for (int kb = 0; kb < 1; ++kb) {
        float sc[8];
#pragma unroll
        for (int j = 0; j < 8; ++j) sc[j] = gk ? cs * gk[k0 + kb * 8 + j] : cs;
#pragma unroll
        for (int i = 0; i < 4; ++i) { const int nn = n + i; const int dr = dst0 + (il ? (nn >> 7) * 256 + (nn & 127) : nn);
            v4u o; o.x = pk2(v[kb][0][i] * sc[0], v[kb][1][i] * sc[1]); o.y = pk2(v[kb][2][i] * sc[2], v[kb][3][i] * sc[3]); o.z = pk2(v[kb][4][i] * sc[4], v[kb][5][i] * sc[5]); o.w = pk2(v[kb][6][i] * sc[6], v[kb][7][i] * sc[7]);
            const size_t off = blk ? ((size_t)((dr >> 8) * (ldk >> 6) + ((k0 + kb * 8) >> 6)) * 16384 + (size_t)(dr & 255) * 64 + ((k0 + kb * 8) & 63)) : ((size_t)dr * ldk + k0 + kb * 8);
            *(GAS v4u*)(WT + off) = o; }
    }
}
__device__ __forceinline__ void rms_row_to_bf16(const float* xrow, bf16* orow, int lane, float* rinv = nullptr) {
    const GAS f32x4* xr = (const GAS f32x4*)xrow + lane;
    f32x4 v[4]; float s = 0.f;
#pragma unroll
    for (int j = 0; j < 4; ++j) { v[j] = __builtin_nontemporal_load(xr + 64 * j); s += (v[j].x * v[j].x + v[j].y * v[j].y) + (v[j].z * v[j].z + v[j].w * v[j].w); }
    const float q = sqrtf(wave_sum(s) * (1.f / D) + RMS_EPS), r = 1.f / q;
    if (rinv && lane == 0) *rinv = q;
    GAS unsigned long long* o8 = (GAS unsigned long long*)orow + lane;
#pragma unroll
    for (int j = 0; j < 4; ++j) o8[64 * j] = (unsigned long long)pk2(v[j].x * r, v[j].y * r) | ((unsigned long long)pk2(v[j].z * r, v[j].w * r) << 32);
}
#ifndef STAMP
#define STAMP(j) do { } while (0)
#endif
__device__ __forceinline__ void p0_prologue(Frame& F, const Args& args) {
    const int gw = F.vcu * NWAVES + F.wave, NGW = F.G * NWAVES;
    STAMP(0);
    { bf16* MN = (bf16*)(args.ws + WS_MN); for (int m = gw; m < NB * ML; m += NGW) rms_row_to_bf16(args.in[1] + (size_t)m * D, MN + (size_t)m * D, F.lane);
      bf16* WQ = (bf16*)(args.ws + WS_WQRM); const float* Wq = args.in[18]; const float* gq = args.in[16];
      for (int e4 = gw * 64 + F.lane; e4 < D * D / 4; e4 += NGW * 64) { const int c = e4 >> 8; const float sc = gq[c] * (0.0625f * LOG2E); const f32x4 v = ((const GAS f32x4*)Wq)[e4];
          ((GAS unsigned long long*)WQ)[e4] = (unsigned long long)pk2(v.x * sc, v.y * sc) | ((unsigned long long)pk2(v.z * sc, v.w * sc) << 32); } }
    STAMP(1);
    for (int g = gw; g < 12032; g += NGW) {
        int rem = g;
#pragma unroll
        for (int s = 0; s < NSEG; ++s) {
            const SegC sg = seg_c(s);
            const int nblk = (sg.ncols + 255) / 256, nit = (sg.K / 8) * nblk;
            if (rem >= 0 && rem < nit) {
                const float* W = args.in[sg.win]; const float* gk = sg.gin >= 0 ? args.in[sg.gin] : nullptr; bf16* WT = (bf16*)(args.ws + sg.wsoff);
                const int grp = rem / (8 * nblk), r2 = rem % (8 * nblk), nb = r2 >> 3, kb = grp * 8 + (r2 & 7);
                tr_item(W, sg.ldw, 8 * kb, sg.src0 + 256 * nb, sg.ncols - 256 * nb, WT, sg.K, sg.dst0 + (sg.il ? 512 * nb : 256 * nb), sg.il, gk, sg.cs, F.lane, sg.blk);
            }
            rem -= nit;
        }
    }
    bf16* XN = (bf16*)(args.ws + WS_XN);
    { float* RINV0 = (float*)(args.ws + WS_RINV);
      const bool aff = (F.G == 256); const int mstep = aff ? 256 : NGW, mend = aff ? ((F.vcu >> 5) + 1) * SEQ : T;
      for (int mi_ = aff ? (F.vcu >> 5) * SEQ + (F.vcu & 31) * NWAVES + F.wave : gw; mi_ < mend; mi_ += mstep) {
          const int m = aff ? (2 * (F.vcu >> 5) + 1) * SEQ - 256 + 2 * ((F.vcu & 31) * NWAVES + F.wave) - mi_ : mi_;
          rms_row_to_bf16(F.x + (size_t)m * D, XN + (size_t)m * D, F.lane, RINV0 + m); } }
    STAMP(2);
}
__device__ __forceinline__ f32x4 bf4_to_f32(unsigned long long w) { f32x4 r; r.x = __builtin_bit_cast(float, (unsigned)(w & 0xffffu) << 16); r.y = __builtin_bit_cast(float, (unsigned)((w >> 16) & 0xffffu) << 16);
    r.z = __builtin_bit_cast(float, (unsigned)((w >> 32) & 0xffffu) << 16); r.w = __builtin_bit_cast(float, (unsigned)(w >> 48) << 16); return r; }
__device__ __forceinline__ void rowwise_res(Frame& F, const bf16* Yb, const float* g, float alpha, const float* xin, bf16* XN, float* RINV, float* outf, const float* gfin) {
    const int gw = F.vcu * NWAVES + F.wave, NGW = F.G * NWAVES, lane = F.lane;
    f32x4 gv[4], gf[4];
#pragma unroll
    for (int j = 0; j < 4; ++j) { gv[j] = ((const GAS f32x4*)g)[lane + 64 * j]; gf[j] = gfin ? ((const GAS f32x4*)gfin)[lane + 64 * j] : (f32x4){1.f, 1.f, 1.f, 1.f}; }
    const bool aff = (F.G == 256); const int mstep = aff ? 256 : NGW, mend = aff ? ((F.vcu >> 5) + 1) * SEQ : T;
    for (int mi_ = aff ? (F.vcu >> 5) * SEQ + (F.vcu & 31) * NWAVES + F.wave : gw; mi_ < mend; mi_ += mstep) {
        const int m = aff ? (2 * (F.vcu >> 5) + 1) * SEQ - 256 + 2 * ((F.vcu & 31) * NWAVES + F.wave) - mi_ : mi_;
        const GAS unsigned long long* yr = (const GAS unsigned long long*)(Yb + (size_t)m * D) + lane;
        f32x4 v[4], xv[4]; float s = 0.f;
#pragma unroll
        for (int j = 0; j < 4; ++j) v[j] = bf4_to_f32(yr[64 * j]);
        if (xin) { const GAS f32x4* xr = (const GAS f32x4*)(xin + (size_t)m * D) + lane;
#pragma unroll
            for (int j = 0; j < 4; ++j) xv[j] = xr[64 * j]; }
        else { const GAS unsigned long long* xr = (const GAS unsigned long long*)(XN + (size_t)m * D) + lane; const float ri = RINV[m];
#pragma unroll
            for (int j = 0; j < 4; ++j) xv[j] = bf4_to_f32(xr[64 * j]) * ri; }
#pragma unroll
        for (int j = 0; j < 4; ++j) s += (v[j].x * v[j].x + v[j].y * v[j].y) + (v[j].z * v[j].z + v[j].w * v[j].w);
        const float r = alpha / sqrtf(wave_sum(s) * (1.f / D) + RMS_EPS);
        float s2 = 0.f;
#pragma unroll
        for (int j = 0; j < 4; ++j) { xv[j] = xv[j] + v[j] * gv[j] * r; s2 += (xv[j].x * xv[j].x + xv[j].y * xv[j].y) + (xv[j].z * xv[j].z + xv[j].w * xv[j].w); }
        const float q2 = sqrtf(wave_sum(s2) * (1.f / D) + RMS_EPS), r2 = 1.f / q2;
        if (gfin) { GAS f32x4* xw = (GAS f32x4*)(outf + (size_t)m * D) + lane;
#pragma unroll
            for (int j = 0; j < 4; ++j) xw[64 * j] = xv[j] * gf[j] * r2;
        } else {
            GAS unsigned long long* o8 = (GAS unsigned long long*)(XN + (size_t)m * D) + lane;
#pragma unroll
            for (int j = 0; j < 4; ++j) o8[64 * j] = (unsigned long long)pk2(xv[j].x * r2, xv[j].y * r2) | ((unsigned long long)pk2(xv[j].z * r2, xv[j].w * r2) << 32);
            if (lane == 0) RINV[m] = q2;
        }
    }
}

typedef float f32x16 __attribute__((ext_vector_type(16)));
__device__ __forceinline__ int crow(int r, int hi) { return (r & 3) + 8 * (r >> 2) + 4 * hi; }
__device__ __forceinline__ float logsigmoidf(float x) { return fminf(x, 0.f) - log1pf(expf(-fabsf(x))); }
__device__ __forceinline__ float logsig_fast(float x) { const float t = __builtin_amdgcn_exp2f(-fabsf(x) * LOG2E); return fminf(x, 0.f) - 0.6931471805599453f * __builtin_amdgcn_logf(1.0f + t); }
__device__ __forceinline__ void p0_wsmall(Frame& F, const Args& args) {
    const float* W = args.in[8]; const float* g = args.in[7]; bf16* WSM = (bf16*)(args.ws + WS_WSM);
    const int gt = (F.vcu * NWAVES + F.wave) * 64 + F.lane, NT_ = F.G * NWAVES * 64;
    for (int e = gt; e < 32 * D; e += NT_) { const int c = e >> 10, k = e & 1023; float v = 0.f;
        if (c < 8) v = W[(size_t)k * INW + 1536 + c] * g[k]; else if (c < 24) v = W[(size_t)k * INW + 2568 + (c - 8)] * g[k];
        WSM[e] = (bf16)f2bf(v); }
}
__device__ __forceinline__ void skinny_half(Frame& F, const Args& args, int hp) {
    const bf16* XN = (const bf16*)(args.ws + WS_XN) + (size_t)hp * 128 * D; const bf16* WSM = (const bf16*)(args.ws + WS_WSM);
    float* ZSM = (float*)(args.ws + WS_ZSM); float* CLOC = (float*)(args.ws + WS_CLOC); float* TOT = (float*)(args.ws + WS_TOT);
    const int tid = F.tid, lane = F.lane, r32 = lane & 31, hi = lane >> 5, wid = F.wave, rt = wid & 3, kh = wid >> 2;
    constexpr int RP = 272;
    constexpr int BUF = (128 + 32) * RP;
    v4u st[5];
    auto issue = [&](int kb) {
#pragma unroll
        for (int i = 0; i < 5; ++i) { const int p = tid + 512 * i; const int r = (p & 2047) >> 4, ch = p & 15;
            st[i] = (i < 4) ? *(const v4u*)(XN + (size_t)r * D + kb * 128 + 8 * ch) : *(const v4u*)(WSM + (size_t)r * D + kb * 128 + 8 * ch); } };
    auto commit = [&](int buf) {
#pragma unroll
        for (int i = 0; i < 5; ++i) { const int p = tid + 512 * i; const int r = (p & 2047) >> 4, ch = p & 15;
            *(LAS v4u*)(F.lds + buf * BUF + ((i < 4) ? r : 128 + r) * RP + 16 * ch) = st[i]; } };
    f32x16 acc = {};
    issue(0); commit(0);
    for (int kb = 0; kb < 8; ++kb) {
        if (kb + 1 < 8) issue(kb + 1);
        LDS_WAIT(); __syncthreads();
        { LAS const unsigned char* ab = F.lds + (kb & 1) * BUF + (rt * 32 + r32) * RP + kh * 128 + hi * 16;
          LAS const unsigned char* bb_ = F.lds + (kb & 1) * BUF + (128 + r32) * RP + kh * 128 + hi * 16;
#pragma unroll
          for (int s = 0; s < 4; ++s) acc = __builtin_amdgcn_mfma_f32_32x32x16_bf16(*(LAS const bf16x8*)(ab + 32 * s), *(LAS const bf16x8*)(bb_ + 32 * s), acc, 0, 0, 0); }
        if (kb + 1 < 8) commit((kb + 1) & 1);
    }
    LDS_WAIT(); __syncthreads();
    LAS float* red = (LAS float*)(F.lds);
    LAS float* lf = (LAS float*)(F.lds + 16384);
    if (kh == 1) {
#pragma unroll
        for (int r = 0; r < 16; ++r) red[(rt * 16 + r) * 64 + lane] = acc[r];
    }
    LDS_WAIT(); __syncthreads();
    if (kh == 0) {
        const float bf_ = (r32 < 8) ? args.in[9][r32] : 0.f;
#pragma unroll
        for (int r = 0; r < 16; ++r) { const float v = acc[r] + red[(rt * 16 + r) * 64 + lane]; const int rr = rt * 32 + crow(r, hi);
            ZSM[(size_t)(hp * 128 + rr) * 32 + r32] = v;
            if (r32 < 8) lf[rr * 8 + r32] = logsig_fast(v + bf_); }
    }
    LDS_WAIT(); __syncthreads();
    { const int h = wid; const float v0 = lf[(2 * lane) * 8 + h], v1 = v0 + lf[(2 * lane + 1) * 8 + h];
      float incl = v1;
#pragma unroll
      for (int o = 1; o < 64; o <<= 1) { const float t = __shfl_up(incl, o); if (lane >= o) incl += t; }
      const float excl = incl - v1;
      CLOC[(size_t)(hp * 128 + 2 * lane) * 8 + h] = excl + v0; CLOC[(size_t)(hp * 128 + 2 * lane + 1) * 8 + h] = excl + v1;
      if (lane == 63) TOT[hp * 8 + h] = incl; }
    LDS_WAIT(); __syncthreads();
}

namespace fox {
typedef __attribute__((ext_vector_type(4))) short s16x4;
typedef float f32x2_t __attribute__((ext_vector_type(2))); typedef __bf16 bf16x2_t __attribute__((ext_vector_type(2)));
typedef short v4i16_t __attribute__((ext_vector_type(4)));
typedef LAS const char* lds_cptr;
constexpr int DM = ZW, SLOTB = 8192, NSLOT = 3;
constexpr int L_K = 0, L_V = NSLOT * SLOTB, L_DK = 2 * NSLOT * SLOTB, L_WS = L_DK + 16384, L_OST = L_WS + NWAVES * 256, L_END = L_OST + NWAVES * 4096;
static_assert(L_END <= RING_BYTES, "fox LDS");
__device__ __forceinline__ unsigned cvtpk_s(float lo, float hi) { f32x2_t v = {lo, hi}; bf16x2_t b = __builtin_convertvector(v, bf16x2_t); return __builtin_bit_cast(unsigned, b); }
__device__ __forceinline__ void glds16(const void* gsrc, unsigned lds_dst) { unsigned keep;
    asm volatile("s_mov_b32 %0, m0\n\ts_mov_b32 m0, %2\n\ts_nop 0\n\tglobal_load_lds_dwordx4 %1, off\n\ts_mov_b32 m0, %0" : "=&s"(keep) : "v"(gsrc), "s"(lds_dst) : "memory"); }
__device__ __forceinline__ void glds16s(const void* sbase, unsigned voff, unsigned lds_dst) { unsigned keep;
    asm volatile("s_mov_b32 %0, m0\n\ts_mov_b32 m0, %3\n\ts_nop 0\n\tglobal_load_lds_dwordx4 %1, %2\n\ts_mov_b32 m0, %0" : "=&s"(keep) : "v"(voff), "s"(sbase), "s"(lds_dst) : "memory"); }
#define FOX_WAIT_BAR(N) asm volatile("s_waitcnt vmcnt(" #N ") lgkmcnt(0)\n\ts_barrier" ::: "memory")
#define FOX_SBAR() __builtin_amdgcn_sched_barrier(0)
__device__ __forceinline__ void kload8(bf16x8* kf, lds_cptr kp) {
    kf[0] = *(LAS const bf16x8*)(kp);        kf[1] = *(LAS const bf16x8*)(kp + 512);
    kf[2] = *(LAS const bf16x8*)(kp + 2048); kf[3] = *(LAS const bf16x8*)(kp + 2560);
    kf[4] = *(LAS const bf16x8*)(kp + 4096); kf[5] = *(LAS const bf16x8*)(kp + 4608);
    kf[6] = *(LAS const bf16x8*)(kp + 6144); kf[7] = *(LAS const bf16x8*)(kp + 6656);
}
__device__ __forceinline__ void kload2(bf16x8* kf, lds_cptr kp, int j) { kf[2 * j] = *(LAS const bf16x8*)(kp + j * 2048); kf[2 * j + 1] = *(LAS const bf16x8*)(kp + j * 2048 + 512); }
__device__ __forceinline__ s16x4 vtr(lds_cptr p) { return __builtin_bit_cast(s16x4, __builtin_amdgcn_ds_read_tr16_b64_v4i16((LAS v4i16_t*)p)); }
__device__ __forceinline__ void cmask(f32x16& p0, f32x16& p1, int jb, int qrel, int hi) {
    const int kb = 64 * jb + 4 * hi;
#pragma unroll
    for (int r = 0; r < 16; ++r) { const int kv = kb + (r & 3) + 8 * (r >> 2); if (kv > qrel) p0[r] = -INFINITY; if (kv + 32 > qrel) p1[r] = -INFINITY; }
}
__device__ __forceinline__ void prefill(f32x16& c0, f32x16& c1, LAS const float* dkl, int t, int hi, float dq) {
    LAS const f32x4* dk4 = (LAS const f32x4*)dkl + 16 * t + hi;
#pragma unroll
    for (int g = 0; g < 4; ++g) { const f32x4 a = dk4[2 * g], bq = dk4[8 + 2 * g];
#pragma unroll
        for (int i = 0; i < 4; ++i) { c0[4 * g + i] = a[i] - dq; c1[4 * g + i] = bq[i] - dq; } }
}
__device__ __forceinline__ void pv(f32x16* o, int vb, bf16x8 pa0, bf16x8 pa1, bf16x8 pa2, bf16x8 pa3) {
#pragma unroll
    for (int d0 = 0; d0 < 2; ++d0) { s16x4 lo[4], hi[4];
#pragma unroll
        for (int ks = 0; ks < 4; ++ks) {
            asm volatile("ds_read_b64_tr_b16 %0,%1 offset:%c2" : "=&v"(lo[ks]) : "v"(vb), "i"(d0 * 4096 + ks * 1024) : "memory");
            asm volatile("ds_read_b64_tr_b16 %0,%1 offset:%c2" : "=&v"(hi[ks]) : "v"(vb), "i"(d0 * 4096 + ks * 1024 + 512) : "memory"); }
        asm volatile("s_waitcnt lgkmcnt(0)" ::: "memory"); FOX_SBAR();
#define FOX_PK(k) (bf16x8){lo[k][0], lo[k][1], lo[k][2], lo[k][3], hi[k][0], hi[k][1], hi[k][2], hi[k][3]}
        o[d0] = __builtin_amdgcn_mfma_f32_32x32x16_bf16(pa0, FOX_PK(0), o[d0], 0, 0, 0);
        o[d0] = __builtin_amdgcn_mfma_f32_32x32x16_bf16(pa1, FOX_PK(1), o[d0], 0, 0, 0);
        o[d0] = __builtin_amdgcn_mfma_f32_32x32x16_bf16(pa2, FOX_PK(2), o[d0], 0, 0, 0);
        o[d0] = __builtin_amdgcn_mfma_f32_32x32x16_bf16(pa3, FOX_PK(3), o[d0], 0, 0, 0);
#undef FOX_PK
    }
}
__device__ __forceinline__ void fox_unit(Frame& F, const Args& args, int b, int h, int qb, bool stage_dk) {
    const int tid = F.tid, lane = F.lane, r32 = lane & 31, hi = lane >> 5, wid = F.wave;
    const bf16* Zb = (const bf16*)(args.ws + WS_BIG) + (size_t)b * SEQ * DM;
    const float* CLOC = (const float*)(args.ws + WS_CLOC); const float* TOT = (const float*)(args.ws + WS_TOT);
    bf16* OMIX = (bf16*)(args.ws + WS_XNB);
    const unsigned lds0 = (unsigned)(uintptr_t)F.lds;
    LAS float* dkl = (LAS float*)(F.lds + L_DK);
    const int q0 = qb * 256, NTF = (q0 + 256) / 64;
    if (stage_dk) { LAS float* pre = (LAS float*)(F.lds + L_WS);
        if (tid < 64) { const float tv = (lane < 32) ? TOT[(b * 32 + lane) * 8 + h] : 0.f; float incl = tv;
#pragma unroll
            for (int o = 1; o < 32; o <<= 1) { const float t_ = __shfl_up(incl, o); if (lane >= o) incl += t_; }
            if (lane < 32) pre[lane] = incl - tv; }
        LDS_WAIT(); __syncthreads();
        for (int s = tid; s < q0 + 256; s += NWAVES * 64) dkl[s] = -(pre[s >> 7] + CLOC[((size_t)b * SEQ + s) * 8 + h]) * LOG2E; }
    bf16x8 qr[4];
    { const bf16* Qw = Zb + (size_t)(q0 + wid * 32 + r32) * DM + h * 64;
#pragma unroll
      for (int d0 = 0; d0 < 4; ++d0) qr[d0] = *(const bf16x8*)(Qw + d0 * 16 + hi * 8); }
    FOX_WAIT_BAR(0);
    int t0;
    { const int cand = 2 * lane + 2;
      const bool ok = (cand <= NTF - 4) && (dkl[q0] - dkl[64 * cand - 1] > 128.0f);
      t0 = 2 * __builtin_popcountll(__ballot(ok)); }
    const int NT = NTF - t0;
    const float dq = dkl[q0 + wid * 32 + r32];
    LAS const float* dkt = (LAS const float*)(F.lds + L_DK) + 64 * t0;
    const bf16* kbase = Zb + 512 + h * 64 + (size_t)(64 * t0) * DM;
    const bf16* vbase = Zb + 1024 + h * 64 + (size_t)(64 * t0) * DM;
    const unsigned koff = (unsigned)(lane * DM + wid * 8) * 2u;
    const unsigned voff = (unsigned)((16 * (wid & 3) + (lane >> 2)) * DM + (wid >> 2) * 32 + (lane & 3) * 8) * 2u;
    const unsigned kdst = lds0 + L_K + wid * 1024, vdst = lds0 + L_V + wid * 1024;
#define DMA_K(t, slot) glds16s(kbase + (size_t)(t) * 64 * DM, koff, (unsigned)__builtin_amdgcn_readfirstlane(kdst + (slot)))
#define DMA_V(t, slot) glds16s(vbase + (size_t)(t) * 64 * DM, voff, (unsigned)__builtin_amdgcn_readfirstlane(vdst + (slot)))
    const int vb0 = (int)(lds0 + L_V) + ((lane >> 4) & 1) * 32 + (lane & 3) * 8 + (4 * hi + ((lane & 15) >> 2)) * 64;
    const lds_cptr kp0 = (lds_cptr)(F.lds + L_K + hi * 1024 + r32 * 16);
    const lds_cptr vp0 = (lds_cptr)(F.lds + L_V + ((lane >> 4) & 1) * 32 + (lane & 3) * 8 + (4 * hi + ((lane & 15) >> 2)) * 64);
    DMA_K(0, 0); DMA_V(0, 0); DMA_K(1, SLOTB); DMA_K(2, 2 * SLOTB);
    const int qrel = wid * 32 + r32;
    float l_reg = 0.f; f32x16 o[2]; o[0] = f32x16{}; o[1] = f32x16{};
    bf16x8 kf[8];
#define CMASK(P0, P1, t) do { const int jb_ = (t) - (NT - 4); if (jb_ >= 0) cmask(P0, P1, jb_, qrel, hi); } while (0)
    f32x16 pA0, pA1, pB0, pB1;
    int sl_prev = 0, sl_cur = 0, sl_next = SLOTB;
#define ROT() do { sl_prev = sl_cur; sl_cur = sl_next; sl_next = (sl_next == (NSLOT - 1) * SLOTB) ? 0 : sl_next + SLOTB; } while (0)
    FOX_WAIT_BAR(3);
    kload8(kf, kp0); prefill(pA0, pA1, dkt, 0, hi, dq);
    pA0 = __builtin_amdgcn_mfma_f32_32x32x16_bf16(kf[0], qr[0], pA0, 0, 0, 0); pA1 = __builtin_amdgcn_mfma_f32_32x32x16_bf16(kf[1], qr[0], pA1, 0, 0, 0);
    pA0 = __builtin_amdgcn_mfma_f32_32x32x16_bf16(kf[2], qr[1], pA0, 0, 0, 0); pA1 = __builtin_amdgcn_mfma_f32_32x32x16_bf16(kf[3], qr[1], pA1, 0, 0, 0);
    pA0 = __builtin_amdgcn_mfma_f32_32x32x16_bf16(kf[4], qr[2], pA0, 0, 0, 0); pA1 = __builtin_amdgcn_mfma_f32_32x32x16_bf16(kf[5], qr[2], pA1, 0, 0, 0);
    pA0 = __builtin_amdgcn_mfma_f32_32x32x16_bf16(kf[6], qr[3], pA0, 0, 0, 0); pA1 = __builtin_amdgcn_mfma_f32_32x32x16_bf16(kf[7], qr[3], pA1, 0, 0, 0);
    CMASK(pA0, pA1, 0);
#pragma unroll
    for (int r = 0; r < 16; ++r) { pA0[r] = __builtin_amdgcn_exp2f(pA0[r]); pA1[r] = __builtin_amdgcn_exp2f(pA1[r]); }
    FOX_WAIT_BAR(0);
    DMA_K(3, 0); DMA_V(1, SLOTB);
    ROT();
    kload8(kf, kp0 + sl_cur);
    FOX_WAIT_BAR(2);
    s16x4 vlo[8], vhi[8]; v4u pw0, pw1, pw2, pw3;
#define PKW(P, B) cvtpk_s(P[B], P[B + 1])
#define PAF(k) __builtin_bit_cast(bf16x8, pw##k)
#define VFR(i) (bf16x8){vlo[i][0], vlo[i][1], vlo[i][2], vlo[i][3], vhi[i][0], vhi[i][1], vhi[i][2], vhi[i][3]}
#define PIN(x) asm volatile("" : "+v"(x))
#define MF(a, b, c) __builtin_amdgcn_mfma_f32_32x32x16_bf16(a, b, c, 0, 0, 0)
#define GAPA(MFS, A0, A1, A2, A3, W0, W1, PW) do { MFS; sacc += A0; sacc += A1; sacc += A2; sacc += A3; PIN(sacc); W0; W1; PIN(PW); FOX_SBAR(); } while (0)
#define EX(v) __builtin_amdgcn_exp2f(v)
#define GAPB(MFS, X, B) do { MFS; X[B] = EX(X[B]); X[B + 1] = EX(X[B + 1]); X[B + 2] = EX(X[B + 2]); X[B + 3] = EX(X[B + 3]); PIN(X); FOX_SBAR(); } while (0)
#define VRD(i) do { vlo[i] = vtr(vp_ + (((i) >> 2) * 4096 + ((i) & 3) * 1024)); vhi[i] = vtr(vp_ + (((i) >> 2) * 4096 + ((i) & 3) * 1024 + 512)); } while (0)
#define KRD(G, j) do { if (G) { kload2(kf, kp0 + sl_next, j); FOX_SBAR(); } } while (0)
#define STEP(C0, C1, P0, P1, t, GK, GV, GL) do { FOX_SBAR(); \
    const lds_cptr vp_ = vp0 + sl_prev; prefill(C0, C1, dkt, (t), hi, dq); PIN(C0); PIN(C1); FOX_SBAR(); \
    VRD(0); FOX_SBAR(); float sacc = (P0[0] + P0[1]); \
    GAPA(C0 = MF(kf[0], qr[0], C0),  P0[2], P0[3], P0[4], P0[5],     pw0[0] = PKW(P0, 0), pw0[1] = PKW(P0, 2), pw0); \
    VRD(4); FOX_SBAR(); GAPA(C1 = MF(kf[1], qr[0], C1),  P0[6], P0[7], P0[8], P0[9],     pw0[2] = PKW(P0, 4), pw0[3] = PKW(P0, 6), pw0); \
    VRD(1); FOX_SBAR(); GAPA(C0 = MF(kf[2], qr[1], C0),  P0[10], P0[11], P0[12], P0[13], pw1[0] = PKW(P0, 8), pw1[1] = PKW(P0, 10), pw1); \
    VRD(5); FOX_SBAR(); GAPA(C1 = MF(kf[3], qr[1], C1),  P0[14], P0[15], P1[0], P1[1],   pw1[2] = PKW(P0, 12), pw1[3] = PKW(P0, 14), pw1); \
    VRD(2); FOX_SBAR(); GAPA(C0 = MF(kf[4], qr[2], C0),  P1[2], P1[3], P1[4], P1[5],     pw2[0] = PKW(P1, 0), pw2[1] = PKW(P1, 2), pw2); \
    VRD(6); FOX_SBAR(); GAPA(C1 = MF(kf[5], qr[2], C1),  P1[6], P1[7], P1[8], P1[9],     pw2[2] = PKW(P1, 4), pw2[3] = PKW(P1, 6), pw2); \
    VRD(3); FOX_SBAR(); GAPA(C0 = MF(kf[6], qr[3], C0),  P1[10], P1[11], P1[12], P1[13], pw3[0] = PKW(P1, 8), pw3[1] = PKW(P1, 10), pw3); \
    VRD(7); FOX_SBAR(); GAPA(C1 = MF(kf[7], qr[3], C1),  P1[14], P1[15], 0.f, 0.f,       pw3[2] = PKW(P1, 12), pw3[3] = PKW(P1, 14), pw3); \
    l_reg += sacc; \
    if (GK) { DMA_K((t) + 3, sl_cur); } if (GV) { DMA_V((t) + 1, sl_next); } \
    CMASK(C0, C1, t); \
    FOX_SBAR(); \
    GAPB(o[0] = MF(PAF(0), VFR(0), o[0]), C0, 0); \
    GAPB(o[1] = MF(PAF(0), VFR(4), o[1]), C0, 4); \
    KRD(GL, 0); GAPB(o[0] = MF(PAF(1), VFR(1), o[0]), C0, 8); \
    KRD(GL, 1); GAPB(o[1] = MF(PAF(1), VFR(5), o[1]), C0, 12); \
    KRD(GL, 2); GAPB(o[0] = MF(PAF(2), VFR(2), o[0]), C1, 0); \
    KRD(GL, 3); GAPB(o[1] = MF(PAF(2), VFR(6), o[1]), C1, 4); \
    GAPB(o[0] = MF(PAF(3), VFR(3), o[0]), C1, 8); \
    GAPB(o[1] = MF(PAF(3), VFR(7), o[1]), C1, 12); \
    } while (0)
    int t = 1;
#undef CMASK
#define CMASK(P0, P1, t) do { } while (0)
    for (; t + 5 < NT; t += 2) {
        STEP(pB0, pB1, pA0, pA1, t, true, true, true);     FOX_WAIT_BAR(2); ROT();
        STEP(pA0, pA1, pB0, pB1, t + 1, true, true, true); FOX_WAIT_BAR(2); ROT();
    }
#undef CMASK
#define CMASK(P0, P1, t) do { const int jb_ = (t) - (NT - 4); if (jb_ >= 0) cmask(P0, P1, jb_, qrel, hi); } while (0)
#define ENDW(tt) do { if ((tt) + 3 < NT) { FOX_WAIT_BAR(2); } else if ((tt) + 2 < NT) { FOX_WAIT_BAR(1); } else { FOX_WAIT_BAR(0); } } while (0)
    for (; t + 1 < NT; t += 2) {
        STEP(pB0, pB1, pA0, pA1, t, (t + 3 < NT), (t + 1 < NT), (t + 1 < NT));         ENDW(t);     ROT();
        STEP(pA0, pA1, pB0, pB1, t + 1, (t + 4 < NT), (t + 2 < NT), (t + 2 < NT));     ENDW(t + 1); ROT();
    }
    STEP(pB0, pB1, pA0, pA1, NT - 1, false, false, false);
    { float sacc = pB0[0] + pB0[1];
#pragma unroll
      for (int r = 2; r < 16; ++r) sacc += pB0[r];
#pragma unroll
      for (int r = 0; r < 16; ++r) sacc += pB1[r];
      l_reg += sacc;
      pw0 = (v4u){PKW(pB0, 0), PKW(pB0, 2), PKW(pB0, 4), PKW(pB0, 6)}; pw1 = (v4u){PKW(pB0, 8), PKW(pB0, 10), PKW(pB0, 12), PKW(pB0, 14)};
      pw2 = (v4u){PKW(pB1, 0), PKW(pB1, 2), PKW(pB1, 4), PKW(pB1, 6)}; pw3 = (v4u){PKW(pB1, 8), PKW(pB1, 10), PKW(pB1, 12), PKW(pB1, 14)};
      FOX_SBAR(); pv(o, vb0 + sl_cur, PAF(0), PAF(1), PAF(2), PAF(3)); }
    l_reg += __shfl_xor(l_reg, 32);
    LAS float* wsf = (LAS float*)(F.lds + L_WS) + wid * 64;
    if (hi == 0) wsf[r32] = l_reg;
    LDS_WAIT();
    { float ss[16];
#pragma unroll
      for (int r = 0; r < 16; ++r) { const float rl = __builtin_amdgcn_rcpf(wsf[crow(r, hi)]); o[0][r] *= rl; o[1][r] *= rl; ss[r] = o[0][r] * o[0][r] + o[1][r] * o[1][r]; }
#pragma unroll
      for (int off = 1; off < 32; off <<= 1)
#pragma unroll
          for (int r = 0; r < 16; ++r) ss[r] += __shfl_xor(ss[r], off);
      const float g0 = args.in[12][h * 64 + r32], g1 = args.in[12][h * 64 + 32 + r32];
      LAS unsigned short* stg = (LAS unsigned short*)(F.lds + L_OST) + wid * 2048;
#pragma unroll
      for (int r = 0; r < 16; ++r) { const int orow = crow(r, hi); const float rs = 1.0f / sqrtf(ss[r] * (1.0f / 64.0f) + RMS_EPS);
          stg[orow * 64 + r32] = (unsigned short)f2bf(o[0][r] * rs * g0); stg[orow * 64 + 32 + r32] = (unsigned short)f2bf(o[1][r] * rs * g1); }
      LDS_WAIT();
#pragma unroll
      for (int i = 0; i < 4; ++i) { const int row = i * 8 + (lane >> 3), ch = lane & 7; const v4u v = *(LAS const v4u*)(stg + row * 64 + ch * 8);
          *(v4u*)(OMIX + ((size_t)b * SEQ + q0 + wid * 32 + row) * D + h * 64 + ch * 8) = v; } }
    FOX_WAIT_BAR(0);
#undef DMA_K
#undef DMA_V
#undef CMASK
#undef ROT
#undef PKW
#undef PAF
#undef VFR
#undef PIN
#undef MF
#undef GAPA
#undef GAPB
#undef EX
#undef VRD
#undef KRD
#undef STEP
#undef ENDW
}
__device__ __forceinline__ int fox_next(Frame& F, unsigned* qword) {
    volatile LAS unsigned* slot = (volatile LAS unsigned*)(F.lds + L_WS) + 60;
    __syncthreads();
    if (F.tid == 0) *slot = __hip_atomic_fetch_add(qword, 1u, __ATOMIC_RELAXED, __HIP_MEMORY_SCOPE_AGENT);
    __syncthreads();
    return (int)*slot;
}
}
namespace gla {
typedef float f32x2v __attribute__((ext_vector_type(2)));
constexpr size_t WS_DEC = 456 * MiB;
__device__ __forceinline__ bf16* kvn_ptr(unsigned char* ws, int ck) { return (bf16*)(ws + WS_Y + (size_t)(ck >> 8) * Y_SLICE) + (size_t)(ck & 255) * 8192; }
__device__ __forceinline__ bf16* spt_ptr(unsigned char* ws, int ck) { return (bf16*)(ws + WS_Y + (size_t)(ck >> 8) * Y_SLICE + 4 * MiB) + (size_t)(ck & 255) * 8192; }
constexpr int PITCH = 144;
__device__ __forceinline__ float bf2f(unsigned short v) { return __builtin_bit_cast(float, (unsigned)v << 16); }
__device__ __forceinline__ float ex(float x) { return __builtin_amdgcn_exp2f(x * LOG2E); }
__device__ __forceinline__ void stage_vt(LAS unsigned char* VT, const bf16* Zr, int h, int tid) {
#pragma unroll
    for (int i = 0; i < 2; ++i) { const int p = tid + i * 512, c = p >> 4, ch = p & 15;
        const v4u w = *(const v4u*)(Zr + (size_t)c * ZW + 2048 + h * 128 + 8 * ch);
        LAS unsigned short* dst = (LAS unsigned short*)(VT + (8 * ch) * PITCH + 2 * c);
        dst[0 * (PITCH / 2)] = (unsigned short)(w.x & 0xffff); dst[1 * (PITCH / 2)] = (unsigned short)(w.x >> 16);
        dst[2 * (PITCH / 2)] = (unsigned short)(w.y & 0xffff); dst[3 * (PITCH / 2)] = (unsigned short)(w.y >> 16);
        dst[4 * (PITCH / 2)] = (unsigned short)(w.z & 0xffff); dst[5 * (PITCH / 2)] = (unsigned short)(w.z >> 16);
        dst[6 * (PITCH / 2)] = (unsigned short)(w.w & 0xffff); dst[7 * (PITCH / 2)] = (unsigned short)(w.w >> 16); }
}
__device__ __forceinline__ void gla_a_iter(Frame& F, const Args& args, int u) {
    const int lane = F.lane, r32 = lane & 31, hi = lane >> 5, wid = F.wave, cl = wid >> 1, ct = wid & 1;
    const int ck = 4 * u + cl, bh = ck >> 6, n = ck & 63, b = bh >> 2, h = bh & 3;
    const size_t tok0 = (size_t)b * SEQ + n * 64;
    bf16* Zr = (bf16*)(args.ws + WS_BIG) + tok0 * ZW;
    const float* ZSM = (const float*)(args.ws + WS_ZSM);
    bf16* KVNc = kvn_ptr(args.ws, ck); float* DEC = (float*)(args.ws + WS_DEC);
    constexpr int BCP = 68;
    LAS unsigned char* base = F.lds + cl * 31488;
    LAS unsigned char* VIMG = base; LAS float* BC = (LAS float*)base;
    LAS unsigned char* KDT = base + 17408; LAS float* GG = (LAS float*)(base + 17408 + 9216); LAS float* SEG = (LAS float*)(base + 17408 + 9216 + 4096);
    const int tp = ct * 64 + lane, d = lane;
    v4u vv[8];
#pragma unroll
    for (int i = 0; i < 8; ++i) { const int p = tp + 128 * i, s = p >> 4, ch = p & 15; vv[i] = *(const v4u*)(Zr + (size_t)s * ZW + 2048 + h * 128 + 8 * ch); }
    { f32x4 gq[2];
#pragma unroll
      for (int i = 0; i < 2; ++i) { const int p = tp + 128 * i, c = p >> 2, pc = p & 3; gq[i] = *(const f32x4*)(ZSM + (tok0 + c) * 32 + 8 + 4 * pc); }
#pragma unroll
      for (int i = 0; i < 2; ++i) { const int p = tp + 128 * i, c = p >> 2, pc = p & 3; *(LAS f32x4*)(GG + c * 16 + 4 * pc) = gq[i]; } }
    float w[16];
#pragma unroll
    for (int r = 0; r < 16; ++r) w[r] = args.in[10][r * 256 + h * 64 + d];
    const float bgd = args.in[11][h * 64 + d];
    LDS_WAIT(); __syncthreads();
    { float bc[32]; float run = 0.f;
#pragma unroll
      for (int i = 0; i < 32; ++i) { const int c = 32 * ct + i; float a = bgd;
#pragma unroll
          for (int q4 = 0; q4 < 4; ++q4) { const f32x4 g4 = *(LAS const f32x4*)(GG + c * 16 + 4 * q4);
              a = fmaf(g4.x, w[4 * q4], a); a = fmaf(g4.y, w[4 * q4 + 1], a); a = fmaf(g4.z, w[4 * q4 + 2], a); a = fmaf(g4.w, w[4 * q4 + 3], a); }
          run += logsig_fast(a) * (1.0f / 16.0f); bc[i] = run; }
      SEG[ct * 64 + d] = run;
      LDS_WAIT(); __syncthreads();
      const float s0 = SEG[d], s1 = SEG[64 + d], pre = ct ? s0 : 0.f;
#pragma unroll
      for (int i = 0; i < 32; ++i) BC[(32 * ct + i) * BCP + d] = pre + bc[i];
      if (ct == 0) { SEG[128 + d] = s0 + s1; DEC[(size_t)ck * 64 + d] = ex(s0 + s1); } }
    LDS_WAIT(); __syncthreads();
    { const int c = lane; bf16* qp = Zr + (size_t)c * ZW + 1536 + h * 64 + 32 * ct; bf16* kp = Zr + (size_t)c * ZW + 1792 + h * 64 + 32 * ct;
      v4u qv[4], kv[4];
#pragma unroll
      for (int i = 0; i < 4; ++i) { qv[i] = *(const v4u*)(qp + 8 * i); kv[i] = *(const v4u*)(kp + 8 * i); }
#pragma unroll
      for (int i = 0; i < 4; ++i) { float bq[8], tt[8];
          { const f32x4 b0 = *(LAS const f32x4*)(BC + c * BCP + 32 * ct + 8 * i), b1 = *(LAS const f32x4*)(BC + c * BCP + 32 * ct + 8 * i + 4);
            const f32x4 t0 = *(LAS const f32x4*)(SEG + 128 + 32 * ct + 8 * i), t1 = *(LAS const f32x4*)(SEG + 128 + 32 * ct + 8 * i + 4);
            bq[0] = b0.x; bq[1] = b0.y; bq[2] = b0.z; bq[3] = b0.w; bq[4] = b1.x; bq[5] = b1.y; bq[6] = b1.z; bq[7] = b1.w;
            tt[0] = t0.x; tt[1] = t0.y; tt[2] = t0.z; tt[3] = t0.w; tt[4] = t1.x; tt[5] = t1.y; tt[6] = t1.z; tt[7] = t1.w; }
          const unsigned qw[4] = {qv[i].x, qv[i].y, qv[i].z, qv[i].w}, kw[4] = {kv[i].x, kv[i].y, kv[i].z, kv[i].w};
          unsigned qo[4], ko[4];
#pragma unroll
          for (int j2 = 0; j2 < 4; ++j2) { const float q0 = bf2f((unsigned short)(qw[j2] & 0xffff)), q1 = bf2f((unsigned short)(qw[j2] >> 16)), k0 = bf2f((unsigned short)(kw[j2] & 0xffff)), k1 = bf2f((unsigned short)(kw[j2] >> 16));
              const float e0 = ex(bq[2 * j2]), e1 = ex(bq[2 * j2 + 1]), i0 = ex(-bq[2 * j2]), i1 = ex(-bq[2 * j2 + 1]);
              qo[j2] = fox::cvtpk_s(q0 * e0, q1 * e1); ko[j2] = fox::cvtpk_s(k0 * i0, k1 * i1);
              const unsigned kd = fox::cvtpk_s(k0 * ex(tt[2 * j2] - bq[2 * j2]), k1 * ex(tt[2 * j2 + 1] - bq[2 * j2 + 1]));
              const int dd = 32 * ct + 8 * i + 2 * j2;
              *(LAS unsigned short*)(KDT + dd * PITCH + 2 * c) = (unsigned short)(kd & 0xffff); *(LAS unsigned short*)(KDT + (dd + 1) * PITCH + 2 * c) = (unsigned short)(kd >> 16); }
          *(v4u*)(qp + 8 * i) = (v4u){qo[0], qo[1], qo[2], qo[3]}; *(v4u*)(kp + 8 * i) = (v4u){ko[0], ko[1], ko[2], ko[3]}; } }
    LDS_WAIT(); __syncthreads();
#pragma unroll
    for (int i = 0; i < 8; ++i) { const int p = tp + 128 * i, s = p >> 4, ch = p & 15; *(LAS v4u*)(VIMG + (ch >> 2) * 4096 + s * 64 + (ch & 3) * 16) = vv[i]; }
    LDS_WAIT(); __syncthreads();
    { f32x16 acc[4];
      bf16x8 af[4];
#pragma unroll
      for (int ks = 0; ks < 4; ++ks) af[ks] = *(LAS const bf16x8*)(KDT + (32 * ct + r32) * PITCH + (16 * ks + 8 * hi) * 2);
      const fox::lds_cptr vp = (fox::lds_cptr)(VIMG + (8 * hi + ((lane & 15) >> 2)) * 64 + ((lane >> 4) & 1) * 32 + (lane & 3) * 8);
#pragma unroll
      for (int et = 0; et < 4; ++et) { acc[et] = f32x16{};
#pragma unroll
          for (int ks = 0; ks < 4; ++ks) { const fox::s16x4 lo = fox::vtr(vp + et * 4096 + ks * 1024), hh = fox::vtr(vp + et * 4096 + ks * 1024 + 256);
              acc[et] = __builtin_amdgcn_mfma_f32_32x32x16_bf16(af[ks], (bf16x8){lo[0], lo[1], lo[2], lo[3], hh[0], hh[1], hh[2], hh[3]}, acc[et], 0, 0, 0); } }
#pragma unroll
      for (int et = 0; et < 4; ++et) { bf16* dst = KVNc + (size_t)(32 * et + r32) * 64 + 32 * ct + 4 * hi;
#pragma unroll
          for (int g = 0; g < 4; ++g) { v2u o; o.x = pk2(acc[et][4 * g], acc[et][4 * g + 1]); o.y = pk2(acc[et][4 * g + 2], acc[et][4 * g + 3]); *(v2u*)(dst + 8 * g) = o; } } }
    LDS_WAIT(); __syncthreads();
}
__device__ __forceinline__ void gla_b(Frame& F, const Args& args) {
    const float* DEC = (const float*)(args.ws + WS_DEC);
    const int p = ((F.vcu & 31) * NWAVES + F.wave) * 64 + F.lane;
    const int bh = (F.vcu >> 5) * 4 + (p >> 12), j = 2 * (p & 4095), d = j & 63;
    float S0 = 0.f, S1 = 0.f;
    for (int n0 = 0; n0 < 64; n0 += 32) { unsigned kv[32]; float dc0[32], dc1[32];
#pragma unroll
        for (int i = 0; i < 32; ++i) { const int ck = bh * 64 + n0 + i; kv[i] = *(const unsigned*)(kvn_ptr(args.ws, ck) + j);
            const f32x2v dd = *(const f32x2v*)(DEC + (size_t)ck * 64 + d); dc0[i] = dd.x; dc1[i] = dd.y; }
#pragma unroll
        for (int i = 0; i < 32; ++i) { const int ck = bh * 64 + n0 + i; *(unsigned*)(spt_ptr(args.ws, ck) + j) = pk2(S0, S1);
            S0 = fmaf(dc0[i], S0, bf2f((unsigned short)(kv[i] & 0xffff))); S1 = fmaf(dc1[i], S1, bf2f((unsigned short)(kv[i] >> 16))); } }
}
__device__ __forceinline__ void gla_c_iter(Frame& F, const Args& args, int u) {
    const int lane = F.lane, r32 = lane & 31, hi = lane >> 5, wid = F.wave, cl = wid >> 1, ct = wid & 1;
    const int ck = 4 * u + cl, bh = ck >> 6, n = ck & 63, b = bh >> 2, h = bh & 3;
    const size_t tok0 = (size_t)b * SEQ + n * 64;
    const bf16* Zr = (const bf16*)(args.ws + WS_BIG) + tok0 * ZW;
    const bf16* SPTg = spt_ptr(args.ws, ck);
    bf16* OMIX = (bf16*)(args.ws + WS_XNB);
    LAS unsigned char* VIMG = F.lds + cl * 16384;
    LAS unsigned short* stg = (LAS unsigned short*)(F.lds + 65536 + wid * 8192);
    { const int tp = ct * 64 + lane; v4u vv[8];
#pragma unroll
      for (int i = 0; i < 8; ++i) { const int p = tp + 128 * i, s = p >> 4, ch = p & 15; vv[i] = *(const v4u*)(Zr + (size_t)s * ZW + 2048 + h * 128 + 8 * ch); }
#pragma unroll
      for (int i = 0; i < 8; ++i) { const int p = tp + 128 * i, s = p >> 4, ch = p & 15; *(LAS v4u*)(VIMG + (ch >> 2) * 4096 + s * 64 + (ch & 3) * 16) = vv[i]; } }
    bf16x8 qd[4], ki0[4], ki1[4];
    { const bf16* qp = Zr + (size_t)(32 * ct + r32) * ZW + 1536 + h * 64 + 8 * hi; const bf16* kp = Zr + (size_t)r32 * ZW + 1792 + h * 64 + 8 * hi;
#pragma unroll
      for (int ks = 0; ks < 4; ++ks) { qd[ks] = *(const bf16x8*)(qp + 16 * ks); ki0[ks] = *(const bf16x8*)(kp + 16 * ks); ki1[ks] = ct ? *(const bf16x8*)(kp + (size_t)32 * ZW + 16 * ks) : ki0[ks]; } }
    f32x16 p0 = {}, p1 = {};
#pragma unroll
    for (int ks = 0; ks < 4; ++ks) p0 = __builtin_amdgcn_mfma_f32_32x32x16_bf16(ki0[ks], qd[ks], p0, 0, 0, 0);
    if (ct) {
#pragma unroll
        for (int ks = 0; ks < 4; ++ks) p1 = __builtin_amdgcn_mfma_f32_32x32x16_bf16(ki1[ks], qd[ks], p1, 0, 0, 0);
    }
#pragma unroll
    for (int r = 0; r < 16; ++r) { const bool keep = crow(r, hi) <= r32; if (ct) { if (!keep) p1[r] = 0.f; } else { if (!keep) p0[r] = 0.f; } }
    v4u pw0, pw1, pw2, pw3;
    pw0 = (v4u){fox::cvtpk_s(p0[0], p0[1]), fox::cvtpk_s(p0[2], p0[3]), fox::cvtpk_s(p0[4], p0[5]), fox::cvtpk_s(p0[6], p0[7])};
    pw1 = (v4u){fox::cvtpk_s(p0[8], p0[9]), fox::cvtpk_s(p0[10], p0[11]), fox::cvtpk_s(p0[12], p0[13]), fox::cvtpk_s(p0[14], p0[15])};
    pw2 = (v4u){fox::cvtpk_s(p1[0], p1[1]), fox::cvtpk_s(p1[2], p1[3]), fox::cvtpk_s(p1[4], p1[5]), fox::cvtpk_s(p1[6], p1[7])};
    pw3 = (v4u){fox::cvtpk_s(p1[8], p1[9]), fox::cvtpk_s(p1[10], p1[11]), fox::cvtpk_s(p1[12], p1[13]), fox::cvtpk_s(p1[14], p1[15])};
    f32x16 o[4];
    { bf16x8 sf[4][4];
#pragma unroll
      for (int et = 0; et < 4; ++et)
#pragma unroll
          for (int ks = 0; ks < 4; ++ks) sf[et][ks] = *(const bf16x8*)(SPTg + (size_t)(32 * et + r32) * 64 + 8 * hi + 16 * ks);
#pragma unroll
      for (int et = 0; et < 4; ++et) { o[et] = f32x16{};
#pragma unroll
          for (int ks = 0; ks < 4; ++ks) o[et] = __builtin_amdgcn_mfma_f32_32x32x16_bf16(qd[ks], sf[et][ks], o[et], 0, 0, 0); } }
    LDS_WAIT(); asm volatile("s_waitcnt vmcnt(0)" ::: "memory"); __syncthreads();
    { const fox::lds_cptr vp = (fox::lds_cptr)(VIMG + ((lane >> 4) & 1) * 32 + (lane & 3) * 8 + (4 * hi + ((lane & 15) >> 2)) * 64);
#pragma unroll
      for (int et = 0; et < 4; ++et) { fox::s16x4 lo[4], hh[4];
#pragma unroll
          for (int ks = 0; ks < 4; ++ks) { lo[ks] = fox::vtr(vp + et * 4096 + ks * 1024); hh[ks] = fox::vtr(vp + et * 4096 + ks * 1024 + 512); }
#define GLA_PK(k) (bf16x8){lo[k][0], lo[k][1], lo[k][2], lo[k][3], hh[k][0], hh[k][1], hh[k][2], hh[k][3]}
          o[et] = __builtin_amdgcn_mfma_f32_32x32x16_bf16(__builtin_bit_cast(bf16x8, pw0), GLA_PK(0), o[et], 0, 0, 0);
          o[et] = __builtin_amdgcn_mfma_f32_32x32x16_bf16(__builtin_bit_cast(bf16x8, pw1), GLA_PK(1), o[et], 0, 0, 0);
          if (ct) { o[et] = __builtin_amdgcn_mfma_f32_32x32x16_bf16(__builtin_bit_cast(bf16x8, pw2), GLA_PK(2), o[et], 0, 0, 0);
                    o[et] = __builtin_amdgcn_mfma_f32_32x32x16_bf16(__builtin_bit_cast(bf16x8, pw3), GLA_PK(3), o[et], 0, 0, 0); }
#undef GLA_PK
      } }
    { float ss[16];
#pragma unroll
      for (int r = 0; r < 16; ++r) ss[r] = (o[0][r] * o[0][r] + o[1][r] * o[1][r]) + (o[2][r] * o[2][r] + o[3][r] * o[3][r]);
#pragma unroll
      for (int off = 1; off < 32; off <<= 1)
#pragma unroll
          for (int r = 0; r < 16; ++r) ss[r] += __shfl_xor(ss[r], off);
#pragma unroll
      for (int r = 0; r < 16; ++r) { const float rs = 1.0f / sqrtf(ss[r] * (1.0f / 128.0f) + RMS_EPS); const int orow = crow(r, hi);
#pragma unroll
          for (int et = 0; et < 4; ++et) stg[orow * 128 + 32 * et + r32] = (unsigned short)f2bf(o[et][r] * rs); } }
    LDS_WAIT();
    { const int ch = lane & 15; const float* gp = args.in[13] + h * 128 + ch * 8; const f32x4 g0 = *(const f32x4*)gp, g1 = *(const f32x4*)(gp + 4);
      v4u grv[8];
#pragma unroll
      for (int i = 0; i < 8; ++i) grv[i] = *(const v4u*)(Zr + (size_t)(32 * ct + i * 4 + (lane >> 4)) * ZW + 2560 + h * 128 + ch * 8);
#pragma unroll
      for (int i = 0; i < 8; ++i) { const int row = i * 4 + (lane >> 4);
          const v4u ov = *(LAS const v4u*)(stg + row * 128 + ch * 8);
          const v4u gr = grv[i];
          float x[8], q[8];
          x[0] = bf2f((unsigned short)(ov.x & 0xffff)); x[1] = bf2f((unsigned short)(ov.x >> 16)); x[2] = bf2f((unsigned short)(ov.y & 0xffff)); x[3] = bf2f((unsigned short)(ov.y >> 16));
          x[4] = bf2f((unsigned short)(ov.z & 0xffff)); x[5] = bf2f((unsigned short)(ov.z >> 16)); x[6] = bf2f((unsigned short)(ov.w & 0xffff)); x[7] = bf2f((unsigned short)(ov.w >> 16));
          q[0] = bf2f((unsigned short)(gr.x & 0xffff)); q[1] = bf2f((unsigned short)(gr.x >> 16)); q[2] = bf2f((unsigned short)(gr.y & 0xffff)); q[3] = bf2f((unsigned short)(gr.y >> 16));
          q[4] = bf2f((unsigned short)(gr.z & 0xffff)); q[5] = bf2f((unsigned short)(gr.z >> 16)); q[6] = bf2f((unsigned short)(gr.w & 0xffff)); q[7] = bf2f((unsigned short)(gr.w >> 16));
          const float gg[8] = {g0.x, g0.y, g0.z, g0.w, g1.x, g1.y, g1.z, g1.w};
          float y[8];
#pragma unroll
          for (int j = 0; j < 8; ++j) y[j] = x[j] * gg[j] * q[j] * __builtin_amdgcn_rcpf(1.0f + __builtin_amdgcn_exp2f(-LOG2E * q[j]));
          v4u w; w.x = pk2(y[0], y[1]); w.y = pk2(y[2], y[3]); w.z = pk2(y[4], y[5]); w.w = pk2(y[6], y[7]);
          *(v4u*)(OMIX + (tok0 + 32 * ct + row) * D + 512 + h * 128 + ch * 8) = w; } }
    LDS_WAIT(); __syncthreads();
}
}


struct KvmOrder {
    int c;
    __device__ __forceinline__ bool next(int i, pg8::Unit& u) const { if (i > 0 || c >= 64) return false; u.pm = c >> 3; u.pn = c & 7; u.aoff = (long)u.pm * 256 * D; u.boff = (long)u.pn * 256 * D; return true; }
    __device__ __forceinline__ void a_ready(const pg8::Unit&) const {}
    __device__ __forceinline__ void done(const pg8::Unit&) const {}
};
#define XL_CNT(j) (3520 + 64 * (j))
#define XL_GEN(j) (4544 + 64 * (j))
#define XL_Q(j)   (5568 + 64 * (j))
__device__ __forceinline__ void xcc_local_barrier(unsigned* bar, unsigned x) {
    asm volatile("s_waitcnt vmcnt(0)" ::: "memory");
    __syncthreads();
    if (threadIdx.x == 0) {
        __builtin_amdgcn_s_waitcnt(0);
        const unsigned old = xb_add(&bar[XL_CNT(x)], 1u), gen = old / 32u;
        if (old + 1u == (gen + 1u) * 32u) xb_add(&bar[XL_GEN(x)], 1u);
        else XB_SPIN(xb_ld(&bar[XL_GEN(x)]) == gen, bar);
        __builtin_amdgcn_fence(__ATOMIC_ACQUIRE, "agent");
        asm volatile("s_waitcnt vmcnt(0)" ::: "memory");
    }
    __syncthreads();
}
struct MemPrepOrder {
    int c;
    __device__ __forceinline__ bool next(int i, pg8::Unit& u) const { if (i > 0 || c >= 256) return false; const int r = c & 31, b = c >> 5, h = (r >> 2) & 3, t4 = r & 3;
        if (r < 16) { u.pm = h; u.pn = t4; u.aoff = (long)(WS_KVM / 2) + (long)(b * 256) * 2048 + h * 256; u.boff = (long)(WS_WQRM / 2) + (long)(t4 * 256) * D + h * 256; }
        else { u.pm = t4; u.pn = h; u.aoff = (long)(WS_WOT / 2) + (long)(t4 * 256) * D + h * 256; u.boff = (long)(WS_KVM / 2) + (long)(b * 256) * 2048 + 1024 + h * 256; }
        return true; }
    __device__ __forceinline__ void a_ready(const pg8::Unit&) const {}
    __device__ __forceinline__ void done(const pg8::Unit&) const {}
};
#ifndef FFN_SPLIT
#define FFN_SPLIT 6
#endif
#ifndef WARM
#define WARM 4
#endif
#ifndef WGM_FFN
#define WGM_FFN 8
#endif
#ifndef WGM_MIX
#define WGM_MIX 2
#endif
#ifndef PG8_SP2
#define PG8_SP2 true
#endif
#ifndef PG8_ALIGN
#define PG8_ALIGN true
#endif

__device__ __forceinline__ void warm(Frame& F, const unsigned char* p, size_t bytes) {
    for (size_t off = ((size_t)(F.vcu * NWAVES + F.wave) * 64 + F.lane) * 128; off < bytes; off += (size_t)2048 * 64 * 128)
        __builtin_amdgcn_global_load_lds((const unsigned*)(p + off), (LAS unsigned*)(F.lds + TAB_OFF), 16, 0, 0);
}
__global__ void __launch_bounds__(NWAVES * 64, 2) mk_fwd(Args args) {
    extern __shared__ __attribute__((aligned(16))) unsigned char lds[];
    Frame F;
    F.lds = (LAS unsigned char*)lds;
    F.tid = threadIdx.x; F.lane = F.tid & 63; F.wave = __builtin_amdgcn_readfirstlane(F.tid >> 6);
    F.G = gridDim.x; { const int bx = blockIdx.x; F.vcu = (F.G % 8 == 0) ? (bx % 8) * (F.G / 8) + bx / 8 : bx; }
    F.x = args.in[0]; F.out = args.out; F.ws = args.ws;
    unsigned char* ws = args.ws;
    bf16* XN = (bf16*)(ws + WS_XN); bf16* HB = (bf16*)(ws + WS_BIG); bf16* Y = (bf16*)(ws + WS_Y); bf16* XNB = (bf16*)(ws + WS_XNB); float* RINV = (float*)(ws + WS_RINV);
    const int lo = args.ph_lo, hi = args.ph_hi;
#define IN(k) (lo <= (k) && (k) < hi)
    for (int u = F.tid; u < (LDS_BYTES - LDSCTL_OFF) / 4; u += NWAVES * 64) ((LAS unsigned*)(F.lds + LDSCTL_OFF))[u] = 0u;
    __syncthreads();
    XcdBarrier bar; bar.bar = (unsigned*)(ws + WS_CTL) + CW_BAR; bar.x = 0; bar.st = nullptr;
    volatile LAS unsigned* MISC = (volatile LAS unsigned*)(F.lds + MISC_OFF);
    int cblk = (int)blockIdx.x; bool local_ok = false;
    if (hi - lo > 1) {
        bar.x = xb_xcc_id(); bar.st = MISC + 8;
        if (F.tid == 0) MISC[12] = xb_add(&bar.bar[XB_XCNT(bar.x)], 1u);
    }
#define GRID_SYNC(k) do { if (IN(k) && IN((k) + 1)) { if (local_ok) xcc_local_barrier(bar.bar, bar.x); else xcd_barrier(bar); } } while (0)
    if (IN(0)) { p0_prologue(F, args); p0_wsmall(F, args); }
    GRID_SYNC(0);
    if (hi - lo > 1) {
        if (F.tid == 0) { unsigned below = 0, npop = 0, ok = 1;
            for (unsigned j = 0; j < 16; ++j) { const unsigned c = xb_ld(&bar.bar[XB_XCNT(j)]); if (c) { ++npop; if (c != 32u) ok = 0; if (j < bar.x) ++below; } }
            MISC[13] = below; MISC[14] = (ok && npop == 8u && F.G == 256) ? 1u : 0u; }
        __syncthreads();
        if (MISC[14]) { const int bx_ = (int)MISC[13], rk = (int)MISC[12]; local_ok = true; F.vcu = bx_ * 32 + rk; cblk = rk * 8 + bx_; }
        __syncthreads();
        if (!local_ok) return;
#ifdef STAGGER_NS
        if (local_ok) { const unsigned long long t0 = __builtin_amdgcn_s_memrealtime(), ticks = (unsigned long long)(F.vcu >> 5) * STAGGER_NS / 10;
            while (__builtin_amdgcn_s_memrealtime() - t0 < ticks) __builtin_amdgcn_s_sleep(8); }
#endif
    }
    const int bb = F.vcu >> 5;
    unsigned char* BIGb = ws + WS_BIG + (size_t)bb * BIG_SLICE;
    bf16* HBb = (bf16*)BIGb - (size_t)(16 * bb) * ((size_t)256 * DFF);
    bf16* Pb = (bf16*)BIGb - (size_t)(16 * bb) * ((size_t)256 * D);
    if (IN(1)) {
        if (WARM & 1) warm(F, ws + WS_WGU1, 16 * MiB + 512 * 1024);
        pg8::Gemm g{XN, (const bf16*)(ws + WS_WGU1), D, D, D}; pg8::StaticOrder S; S.init(T, NGU, F.G, cblk, D, D); S.wgm = WGM_FFN;
        pg8::EpiSwiGLU E{HBb, DFF / 64};
        pg8::Gemm g2{HBb, (const bf16*)(ws + WS_WD1), 64, 64, DFF, 256 * 64 * 2, 256 * 64 * 2}; pg8::StaticOrder S2; S2.init(T, D, F.G, cblk, 64, 64); S2.apanel = (long)256 * DFF; S2.bpanel = (long)256 * DFF;
        pg8::EpiBf16<0> E2{Y, D, nullptr, 0, 0, 1.f};
        S.i0 = 0; S.i1 = FFN_SPLIT; pg8::gemm_phase<pg8::EpiSwiGLU, pg8::StaticOrder, PG8_ALIGN, PG8_SP2>(F.lds + RING_OFF, g, S, E);
        if (local_ok) xcc_local_barrier(bar.bar, bar.x); else xcd_barrier(bar);
        S2.i0 = 0; S2.i1 = 1; pg8::gemm_phase<pg8::EpiBf16<0>, pg8::StaticOrder, PG8_ALIGN, PG8_SP2>(F.lds + RING_OFF, g2, S2, E2);
        __syncthreads();
        S.i0 = FFN_SPLIT; S.i1 = 1 << 30; pg8::gemm_phase<pg8::EpiSwiGLU, pg8::StaticOrder, PG8_ALIGN, PG8_SP2>(F.lds + RING_OFF, g, S, E);
    }
    GRID_SYNC(1);
    if (IN(2)) {
        pg8::Gemm g{HBb, (const bf16*)(ws + WS_WD1), 64, 64, DFF, 256 * 64 * 2, 256 * 64 * 2}; pg8::StaticOrder S; S.init(T, D, F.G, cblk, 64, 64); S.apanel = (long)256 * DFF; S.bpanel = (long)256 * DFF; S.i0 = 1;
        pg8::EpiBf16<0> E{Y, D, nullptr, 0, 0, 1.f};
        pg8::gemm_phase<pg8::EpiBf16<0>, pg8::StaticOrder, PG8_ALIGN, PG8_SP2>(F.lds + RING_OFF, g, S, E);
    }
    GRID_SYNC(2);
    if (IN(3)) {
        rowwise_res(F, Y, args.in[6], 0.5f, nullptr, XN, RINV, nullptr, nullptr);
        if (WARM & 2) warm(F, ws + WS_WIN, 7 * MiB);
    }
    GRID_SYNC(3);
    if (IN(4)) {
        pg8::Gemm g{XN, (const bf16*)(ws + WS_WIN), D, D, D}; pg8::StaticOrder S; S.init(T, ZW, F.G, cblk, D, D); S.wgm = WGM_MIX;
        pg8::EpiBf16<0> E{HB, ZW, nullptr, 0, 0, 1.f};
        pg8::gemm_phase<pg8::EpiBf16<0>, pg8::StaticOrder, PG8_ALIGN, PG8_SP2>(F.lds + RING_OFF, g, S, E);
        __syncthreads();
        skinny_half(F, args, F.vcu);
    }
    GRID_SYNC(4);
    if (IN(5)) {
        if (F.G == 256) { for (int k = 0; k < 2; ++k) gla::gla_a_iter(F, args, (F.vcu >> 5) * 64 + (F.vcu & 31) + 32 * k); } else for (int u = F.vcu; u < 512; u += F.G) gla::gla_a_iter(F, args, u);
        { pg8::Gemm g{(const bf16*)(ws + WS_MN), (const bf16*)(ws + WS_WKVT), D, D, D}; KvmOrder S{(F.vcu & 31) < 8 ? bb * 8 + (F.vcu & 31) : 64};
          pg8::EpiBf16<0> E{(bf16*)(ws + WS_KVM), 2048, nullptr, 0, 0, 1.f};
          pg8::gemm_phase<pg8::EpiBf16<0>, KvmOrder, PG8_ALIGN, PG8_SP2>(F.lds + RING_OFF, g, S, E); }
        { unsigned* qword = (unsigned*)(ws + WS_CTL) + CW_BAR + XL_Q(bar.x);
          for (;;) { const int ui = fox::fox_next(F, qword); if (ui >= 128) break;
              fox::fox_unit(F, args, bb, ui & 7, 15 - (ui >> 3), true); } } }
    GRID_SYNC(5);
    if (IN(6)) { gla::gla_b(F, args); }
    GRID_SYNC(6);
    if (IN(7)) { if (F.G == 256) { for (int k = 0; k < 2; ++k) gla::gla_c_iter(F, args, (F.vcu >> 5) * 64 + (F.vcu & 31) + 32 * k); } else for (int u = F.vcu; u < 512; u += F.G) gla::gla_c_iter(F, args, u); }
    GRID_SYNC(7);
    if (IN(8)) {
        { pg8::Gemm g{XNB, (const bf16*)(ws + WS_WOUT), D, D, D}; pg8::StaticOrder S; S.init(T, D, F.G, cblk, D, D); S.wgm = 8;
          pg8::EpiBf16<0> E{Y, D, nullptr, 0, 0, 1.f};
          pg8::gemm_phase<pg8::EpiBf16<0>, pg8::StaticOrder, PG8_ALIGN, PG8_SP2>(F.lds + RING_OFF, g, S, E); }
    }
    GRID_SYNC(8);
    if (IN(9)) {
        rowwise_res(F, Y, args.in[15], 1.0f, nullptr, XN, RINV, nullptr, nullptr);
        __syncthreads();
        { const bool t0 = (F.vcu & 31) < 16;
          pg8::Gemm g{(const bf16*)ws, (const bf16*)ws, t0 ? 2048 : D, t0 ? D : 2048, 256}; MemPrepOrder S{F.vcu};
          pg8::EpiBf16<0> E{(bf16*)(BIGb + (t0 ? SL_WQK : SL_VWOT)), D, nullptr, 0, 0, 1.f};
          pg8::gemm_phase<pg8::EpiBf16<0>, MemPrepOrder, PG8_ALIGN, PG8_SP2>(F.lds + RING_OFF, g, S, E); }
    }
    GRID_SYNC(9);
    if (IN(10)) {
        pg8::Gemm g{XN, (const bf16*)(BIGb + SL_WQK), D, D, D}; pg8::StaticOrder S; S.init(T, D, F.G, cblk, D, D);
        pg8::EpiSoftmax E{Pb, D, (LAS float*)(F.lds + TAB_OFF)};
        pg8::gemm_phase<pg8::EpiSoftmax, pg8::StaticOrder, true, PG8_SP2>(F.lds + RING_OFF, g, S, E);
    }
    GRID_SYNC(10);
    if (IN(11)) {
        pg8::Gemm g{Pb, (const bf16*)(BIGb + SL_VWOT), D, D, D}; pg8::StaticOrder S; S.init(T, D, F.G, cblk, D, D);
        pg8::EpiBf16<0> E{Y, D, nullptr, 0, 0, 1.f};
        pg8::gemm_phase<pg8::EpiBf16<0>, pg8::StaticOrder, PG8_ALIGN, PG8_SP2>(F.lds + RING_OFF, g, S, E);
    }
    GRID_SYNC(11);
    if (IN(12)) {
        rowwise_res(F, Y, args.in[21], 1.0f, nullptr, XN, RINV, nullptr, nullptr);
        if (WARM & 4) warm(F, ws + WS_WGU2, 16 * MiB + 512 * 1024);
    }
    GRID_SYNC(12);
    if (IN(13)) {
        pg8::Gemm g{XN, (const bf16*)(ws + WS_WGU2), D, D, D}; pg8::StaticOrder S; S.init(T, NGU, F.G, cblk, D, D); S.wgm = WGM_FFN;
        pg8::EpiSwiGLU E{HBb, DFF / 64};
        pg8::Gemm g2{HBb, (const bf16*)(ws + WS_WD2), 64, 64, DFF, 256 * 64 * 2, 256 * 64 * 2}; pg8::StaticOrder S2; S2.init(T, D, F.G, cblk, 64, 64); S2.apanel = (long)256 * DFF; S2.bpanel = (long)256 * DFF;
        pg8::EpiBf16<0> E2{Y, D, nullptr, 0, 0, 1.f};
        S.i0 = 0; S.i1 = FFN_SPLIT; pg8::gemm_phase<pg8::EpiSwiGLU, pg8::StaticOrder, PG8_ALIGN, PG8_SP2>(F.lds + RING_OFF, g, S, E);
        if (local_ok) xcc_local_barrier(bar.bar, bar.x); else xcd_barrier(bar);
        S2.i0 = 0; S2.i1 = 1; pg8::gemm_phase<pg8::EpiBf16<0>, pg8::StaticOrder, PG8_ALIGN, PG8_SP2>(F.lds + RING_OFF, g2, S2, E2);
        __syncthreads();
        S.i0 = FFN_SPLIT; S.i1 = 1 << 30; pg8::gemm_phase<pg8::EpiSwiGLU, pg8::StaticOrder, PG8_ALIGN, PG8_SP2>(F.lds + RING_OFF, g, S, E);
    }
    GRID_SYNC(13);
    if (IN(14)) {
        pg8::Gemm g{HBb, (const bf16*)(ws + WS_WD2), 64, 64, DFF, 256 * 64 * 2, 256 * 64 * 2}; pg8::StaticOrder S; S.init(T, D, F.G, cblk, 64, 64); S.apanel = (long)256 * DFF; S.bpanel = (long)256 * DFF; S.i0 = 1;
        pg8::EpiBf16<0> E{Y, D, nullptr, 0, 0, 1.f};
        pg8::gemm_phase<pg8::EpiBf16<0>, pg8::StaticOrder, PG8_ALIGN, PG8_SP2>(F.lds + RING_OFF, g, S, E);
    }
    GRID_SYNC(14);
    if (IN(15)) {
        rowwise_res(F, Y, args.in[26], 0.5f, nullptr, XN, RINV, F.out, args.in[27]);
    }
#undef IN
#undef GRID_SYNC
}
__global__ void unpack_ofox(const bf16* Ob, float* omix) {
    const int t = blockIdx.x;
    for (int c = threadIdx.x; c < 1024; c += 256) omix[(size_t)t * D + c] = __builtin_bit_cast(float, (unsigned)Ob[(size_t)t * D + c] << 16);
}
constexpr int N_PHASES = 16;
extern "C" void kernel_launch(void* const* d_in, const int* in_sizes, int n_in, void* d_out, int out_size, void* d_ws, size_t ws_size, hipStream_t stream) {
    static int grid = 0;
    if (grid == 0) {
        int dev = 0, cus = 0;
        if (n_in != 28 || out_size != T * D || ws_size < WS_END) { fprintf(stderr, "kernel_launch: unexpected problem shape (n_in %d, out %d, ws %zu)\n", n_in, out_size, ws_size); grid = -1; return; }
        if (hipGetDevice(&dev) != hipSuccess || hipDeviceGetAttribute(&cus, hipDeviceAttributeMultiprocessorCount, dev) != hipSuccess) { fprintf(stderr, "kernel_launch: device query failed\n"); grid = -1; return; }
        if (hipFuncSetAttribute((const void*)mk_fwd, hipFuncAttributeMaxDynamicSharedMemorySize, LDS_BYTES) != hipSuccess) { fprintf(stderr, "kernel_launch: hipFuncSetAttribute failed\n"); grid = -1; return; }
        (void)hipGetLastError();
        int per_cu = 0;
        if (hipOccupancyMaxActiveBlocksPerMultiprocessor(&per_cu, (const void*)mk_fwd, NWAVES * 64, LDS_BYTES) != hipSuccess || per_cu < 1) { fprintf(stderr, "kernel_launch: occupancy query reports %d workgroups per CU\n", per_cu); (void)hipGetLastError(); per_cu = 1; }
        grid = cus;
        if (grid != 256) fprintf(stderr, "kernel_launch: %d CUs; this kernel is written for 256\n", grid);
    }
    if (grid < 0) return;
    Args a{};
    for (int i = 0; i < 28; ++i) a.in[i] = (const float*)d_in[i];
    a.out = (float*)d_out; a.ws = (unsigned char*)d_ws;
    if (hipMemsetAsync((char*)d_ws + WS_CTL, 0, CTL_ZERO_BYTES, stream) != hipSuccess) { fprintf(stderr, "kernel_launch: hipMemsetAsync failed\n"); return; }
    a.ph_lo = 0; a.ph_hi = N_PHASES;
    void* kargs[] = {(void*)&a};
    const hipError_t e = hipLaunchCooperativeKernel((const void*)mk_fwd, dim3(grid), dim3(NWAVES * 64), kargs, LDS_BYTES, stream);
    if (e != hipSuccess) fprintf(stderr, "kernel_launch: cooperative launch failed: %s (grid %d)\n", hipGetErrorString(e), grid);
}
```
